# Optimizing an MI355X kernel written in HIP

```python
import jax, jax.numpy as jnp
from jax import lax
import numpy as np

D_MODEL = 1024
BATCH = 4
SEQ = 8192
DEPTH = 1

N_META = 16
MIX_WIDTH = D_MODEL
POOL_WIDTH = MIX_WIDTH // 2
POOL_WINDOWS = (2, 4, 8, 16)
N_POOL_GROUPS = 4
POOL_GROUP = POOL_WIDTH // N_POOL_GROUPS
GLA_HEADS = 4
GLA_VDIM = MIX_WIDTH - POOL_WIDTH
GLA_HEAD_V = GLA_VDIM // GLA_HEADS
GLA_KDIM = GLA_VDIM // 2
GLA_HEAD_K = GLA_KDIM // GLA_HEADS
GATE_RANK = 16
GATE_NORMALIZER = 16.0
CHUNK = 64
N_GROUPS = 4
EXPERTS_PER_GROUP = 4
N_EXPERTS = N_GROUPS * EXPERTS_PER_GROUP
TOP_K_IN_GROUP = 2
EXPERT_HIDDEN = D_MODEL // 4
EPS = 1e-6
IN_COLS = POOL_WIDTH + 2 * GLA_KDIM + 2 * GLA_VDIM + GATE_RANK
SPLIT_POINTS = (POOL_WIDTH,
                POOL_WIDTH + GLA_KDIM,
                POOL_WIDTH + 2 * GLA_KDIM,
                POOL_WIDTH + 2 * GLA_KDIM + GLA_VDIM,
                POOL_WIDTH + 2 * GLA_KDIM + 2 * GLA_VDIM)

kernel_name = "hymba_pool_gla_hmoe_block"


def rmsnorm(x, w):
    xf = x.astype(jnp.float32)
    y = xf * lax.rsqrt(jnp.mean(xf * xf, axis=-1, keepdims=True) + EPS)
    return (y * w.astype(jnp.float32)).astype(x.dtype)


def pool_mixer(u, pool_w, pool_scale):
    B, L, _ = u.shape
    uf = u.astype(jnp.float32).reshape(B, L, N_POOL_GROUPS, POOL_GROUP)
    cs = jnp.concatenate([jnp.zeros((B, 1, N_POOL_GROUPS, POOL_GROUP), jnp.float32),
                          jnp.cumsum(uf, axis=1)], axis=1)
    t = jnp.arange(L)
    outs = []
    for g, w in enumerate(POOL_WINDOWS):
        lo = jnp.maximum(t + 1 - w, 0)
        cs_g = cs[:, :, g]
        win_sum = cs_g[:, 1:] - cs_g[:, lo]
        cnt = (t + 1 - lo).astype(jnp.float32)[None, :, None]
        outs.append(win_sum / cnt - uf[:, :, g])
    pooled = jnp.stack(outs, axis=2)
    mixed = jnp.einsum('blgc,gcd->blgd', pooled, pool_w.astype(jnp.float32))
    y = mixed.reshape(B, L, POOL_WIDTH) * pool_scale.astype(jnp.float32)
    return y.astype(u.dtype)


def gla_mixer(q, k, v, r, g_lr, w_gate_up, b_gate, gla_norm_w):
    B, L, _ = q.shape
    f32 = jnp.float32
    log_a = jax.nn.log_sigmoid(g_lr.astype(f32) @ w_gate_up.astype(f32)
                               + b_gate.astype(f32)) / GATE_NORMALIZER
    pad = CHUNK - N_META

    def heads(a, dh):
        a = jnp.pad(a.astype(f32), ((0, 0), (pad, 0), (0, 0)))
        return a.reshape(B, -1, CHUNK, GLA_HEADS, dh).transpose(0, 3, 1, 2, 4)

    qh = heads(q, GLA_HEAD_K) * (GLA_HEAD_K ** -0.5)
    kh = heads(k, GLA_HEAD_K)
    vh = heads(v, GLA_HEAD_V)
    gh = heads(log_a, GLA_HEAD_K)
    b = jnp.cumsum(gh, axis=3)
    b_last = b[:, :, :, -1:, :]
    q_t = qh * jnp.exp(b)
    k_t = kh * jnp.exp(-b)
    k_end = kh * jnp.exp(b_last - b)
    causal = jnp.tril(jnp.ones((CHUNK, CHUNK), dtype=bool))
    scores = jnp.where(causal, jnp.einsum('bhncd,bhnsd->bhncs', q_t, k_t), 0.0)
    o_intra = jnp.einsum('bhncs,bhnsv->bhncv', scores, vh)
    dS = jnp.einsum('bhncd,bhncv->bhndv', k_end, vh)
    decay = jnp.exp(b_last[:, :, :, 0, :])

    def step(S, inp):
        dS_n, dec_n = inp
        return dec_n[..., None] * S + dS_n, S

    S0 = jnp.zeros((B, GLA_HEADS, GLA_HEAD_K, GLA_HEAD_V), f32)
    _, S_start = lax.scan(step, S0, (jnp.moveaxis(dS, 2, 0), jnp.moveaxis(decay, 2, 0)))
    S_start = jnp.moveaxis(S_start, 0, 2)
    o_inter = jnp.einsum('bhncd,bhndv->bhncv', q_t, S_start)
    o = (o_intra + o_inter).transpose(0, 2, 3, 1, 4).reshape(B, -1, GLA_HEADS, GLA_HEAD_V)[:, pad:]
    o = o * lax.rsqrt(jnp.mean(o * o, axis=-1, keepdims=True) + EPS) * gla_norm_w.astype(f32)
    o = o.reshape(B, L, GLA_VDIM) * jax.nn.silu(r.astype(f32))
    return o.astype(q.dtype)


def hier_moe(x, w_rg, b_rg, w_re, b_re, w_gate, w_up, w_down):
    B, L, D = x.shape
    f32 = jnp.float32
    xt = x.reshape(-1, D)
    xf = xt.astype(f32)
    g_logits = xf @ w_rg.astype(f32) + b_rg.astype(f32)
    g_prob = jax.nn.softmax(g_logits, axis=-1)
    g_sel = jnp.argmax(g_logits, axis=-1)
    p_g = jnp.take_along_axis(g_prob, g_sel[:, None], axis=-1)
    e_logits = (xf @ w_re.astype(f32) + b_re.astype(f32)).reshape(-1, N_GROUPS, EXPERTS_PER_GROUP)
    e_logits = jnp.take_along_axis(e_logits, g_sel[:, None, None], axis=1)[:, 0]
    e_prob = jax.nn.softmax(e_logits, axis=-1)
    top_p, top_i = lax.top_k(e_prob, TOP_K_IN_GROUP)
    top_p = top_p / jnp.sum(top_p, axis=-1, keepdims=True)
    weights = p_g * top_p
    expert_id = g_sel[:, None] * EXPERTS_PER_GROUP + top_i
    combine = jnp.sum(jax.nn.one_hot(expert_id, N_EXPERTS, dtype=f32) * weights[..., None], axis=1)
    y = jnp.zeros(xf.shape, f32)
    for e in range(N_EXPERTS):
        h = jax.nn.silu(xt @ w_gate[e]) * (xt @ w_up[e])
        y = y + combine[:, e:e + 1] * (h @ w_down[e]).astype(f32)
    return y.reshape(B, L, D).astype(x.dtype)


def setup_inputs(seed: int = 0) -> dict:
    key = jax.random.key(seed)
    ks = jax.random.split(key, 20)
    n = jax.random.normal
    D = D_MODEL
    return {
        "x": n(ks[0], (BATCH, SEQ, D), jnp.float32),
        "meta_tokens": n(ks[1], (N_META, D), jnp.float32),
        "norm_mix_w": 1.0 + 0.05 * n(ks[2], (DEPTH, D), jnp.float32),
        "w_in": n(ks[3], (DEPTH, D, IN_COLS), jnp.float32) * D ** -0.5,
        "w_gate_up": n(ks[4], (DEPTH, GATE_RANK, GLA_KDIM), jnp.float32) * GATE_RANK ** -0.5,
        "b_gate": 0.1 * n(ks[5], (DEPTH, GLA_KDIM), jnp.float32),
        "gla_norm_w": 1.0 + 0.05 * n(ks[6], (DEPTH, GLA_HEAD_V), jnp.float32),
        "pool_w": n(ks[7], (DEPTH, N_POOL_GROUPS, POOL_GROUP, POOL_GROUP), jnp.float32) * POOL_GROUP ** -0.5,
        "pool_scale": 1.0 + 0.05 * n(ks[8], (DEPTH, POOL_WIDTH), jnp.float32),
        "w_out": n(ks[9], (DEPTH, MIX_WIDTH, D), jnp.float32) * MIX_WIDTH ** -0.5,
        "norm_ffn_w": 1.0 + 0.05 * n(ks[10], (DEPTH, D), jnp.float32),
        "w_router_group": n(ks[11], (DEPTH, D, N_GROUPS), jnp.float32) * D ** -0.5,
        "b_router_group": 0.01 * n(ks[12], (DEPTH, N_GROUPS), jnp.float32),
        "w_router_expert": n(ks[13], (DEPTH, D, N_EXPERTS), jnp.float32) * D ** -0.5,
        "b_router_expert": 0.01 * n(ks[14], (DEPTH, N_EXPERTS), jnp.float32),
        "w_expert_gate": n(ks[15], (DEPTH, N_EXPERTS, D, EXPERT_HIDDEN), jnp.float32) * D ** -0.5,
        "w_expert_up": n(ks[16], (DEPTH, N_EXPERTS, D, EXPERT_HIDDEN), jnp.float32) * D ** -0.5,
        "w_expert_down": n(ks[17], (DEPTH, N_EXPERTS, EXPERT_HIDDEN, D), jnp.float32) * EXPERT_HIDDEN ** -0.5,
        "final_norm_w": 1.0 + 0.05 * n(ks[18], (D,), jnp.float32),
    }


def reference(x, meta_tokens, norm_mix_w, w_in, w_gate_up, b_gate, gla_norm_w, pool_w,
              pool_scale, w_out, norm_ffn_w, w_router_group, b_router_group,
              w_router_expert, b_router_expert, w_expert_gate, w_expert_up,
              w_expert_down, final_norm_w):
    B = x.shape[0]
    meta = jnp.broadcast_to(meta_tokens[None].astype(x.dtype), (B, N_META, D_MODEL))
    h = jnp.concatenate([meta, x], axis=1)
    for l in range(DEPTH):
        u = rmsnorm(h, norm_mix_w[l])
        proj = u @ w_in[l]
        pool_v, q, k, v, r, g_lr = jnp.split(proj, SPLIT_POINTS, axis=-1)
        y_pool = pool_mixer(pool_v, pool_w[l], pool_scale[l])
        y_gla = gla_mixer(q, k, v, r, g_lr, w_gate_up[l], b_gate[l], gla_norm_w[l])
        h = h + jnp.concatenate([y_pool, y_gla], axis=-1) @ w_out[l]
        h = h + hier_moe(rmsnorm(h, norm_ffn_w[l]), w_router_group[l], b_router_group[l],
                         w_router_expert[l], b_router_expert[l], w_expert_gate[l],
                         w_expert_up[l], w_expert_down[l])
    return rmsnorm(h, final_norm_w)[:, N_META:]
```

```cpp
#include <hip/hip_runtime.h>
#include <cstdio>
#include <cstdint>

constexpr int D = 1024, BATCH = 4, SEQ = 8192, NMETA = 16;
constexpr int TR = BATCH * SEQ;
constexpr int R = NMETA + TR;
constexpr int INC = 2064;
constexpr int C_POOL = 0, C_Q = 512, C_K = 768, C_V = 1024, C_R = 1536, C_G = 2048;
constexpr float EPS = 1e-6f;

__device__ __forceinline__ const float* hrow(const float* x, const float* meta, int r) {
    return r < NMETA ? meta + (size_t)r * D : x + (size_t)(r - NMETA) * D;
}

__global__ void k_rstd(const float* x, const float* meta, float* rstd) {
    int r = blockIdx.x; const float* p = hrow(x, meta, r);
    float s = 0.f; for (int i = threadIdx.x; i < D; i += 256) { float v = p[i]; s += v * v; }
    __shared__ float red[256]; red[threadIdx.x] = s; __syncthreads();
    for (int o = 128; o > 0; o >>= 1) { if (threadIdx.x < o) red[threadIdx.x] += red[threadIdx.x + o]; __syncthreads(); }
    if (threadIdx.x == 0) rstd[r] = rsqrtf(red[0] / D + EPS);
}

template <int MODE>
__global__ void k_gemm(const float* A0, const float* meta, const float* nw, const float* rstd, const float* B, float* C, int M, int N, int K) {
    __shared__ float As[16][65], Bs[16][65];
    const int tx = threadIdx.x & 15, ty = threadIdx.x >> 4;
    const int m0 = blockIdx.y * 64, n0 = blockIdx.x * 64;
    float acc[4][4] = {};
    for (int k0 = 0; k0 < K; k0 += 16) {
        for (int i = threadIdx.x; i < 64 * 16; i += 256) {
            int mm = i >> 4, kk = i & 15; int m = m0 + mm; float v = 0.f;
            if (m < M) { if (MODE == 1) v = hrow(A0, meta, m)[k0 + kk] * nw[k0 + kk]; else v = A0[(size_t)m * K + k0 + kk]; }
            As[kk][mm] = v;
        }
        for (int i = threadIdx.x; i < 64 * 16; i += 256) {
            int kk = i >> 6, nn = i & 63; int n = n0 + nn;
            Bs[kk][nn] = n < N ? B[(size_t)(k0 + kk) * N + n] : 0.f;
        }
        __syncthreads();
#pragma unroll
        for (int kk = 0; kk < 16; ++kk) {
            float a[4], b[4];
#pragma unroll
            for (int i = 0; i < 4; ++i) { a[i] = As[kk][ty * 4 + i]; b[i] = Bs[kk][tx * 4 + i]; }
#pragma unroll
            for (int i = 0; i < 4; ++i)
#pragma unroll
                for (int j = 0; j < 4; ++j) acc[i][j] += a[i] * b[j];
        }
        __syncthreads();
    }
    for (int i = 0; i < 4; ++i) { int m = m0 + ty * 4 + i; if (m >= M) continue;
        for (int j = 0; j < 4; ++j) { int n = n0 + tx * 4 + j; if (n >= N) continue;
            float v = acc[i][j];
            if (MODE == 1) v *= rstd[m];
            if (MODE == 2) v += meta[(size_t)m * N + n];
            C[(size_t)m * N + n] = v; } }
}

__global__ void k_pooled(const float* proj, float* pooled) {
    size_t idx = (size_t)blockIdx.x * 256 + threadIdx.x; if (idx >= (size_t)TR * 512) return;
    int m = (int)(idx >> 9), c = (int)(idx & 511); int g = c >> 7; int w = 2 << g;
    int b = m / SEQ, s = m % SEQ;
    float sum = 0.f;
    for (int j = 0; j < w; ++j) { int sp = s - j; int r = sp >= 0 ? NMETA + b * SEQ + sp : NMETA + sp;
        sum += proj[(size_t)r * INC + C_POOL + c]; }
    pooled[idx] = sum / (float)w - proj[(size_t)(NMETA + m) * INC + C_POOL + c];
}
__global__ void k_poolmix(const float* pooled, const float* pool_w, const float* pool_scale, float* ymix) {
    size_t idx = (size_t)blockIdx.x * 256 + threadIdx.x; if (idx >= (size_t)TR * 512) return;
    int m = (int)(idx >> 9), c = (int)(idx & 511); int g = c >> 7, d = c & 127;
    const float* pr = pooled + (size_t)m * 512 + g * 128; const float* wp = pool_w + (size_t)g * 128 * 128 + d;
    float s = 0.f; for (int k = 0; k < 128; ++k) s += pr[k] * wp[(size_t)k * 128];
    ymix[(size_t)m * D + c] = s * pool_scale[c];
}
__global__ void k_decay(const float* proj, const float* wgu, const float* bg, float* dec) {
    size_t idx = (size_t)blockIdx.x * 256 + threadIdx.x; if (idx >= (size_t)R * 256) return;
    int r = (int)(idx >> 8), j = (int)(idx & 255);
    float z = bg[j]; for (int q = 0; q < 16; ++q) z += proj[(size_t)r * INC + C_G + q] * wgu[q * 256 + j];
    float ls = fminf(z, 0.f) - log1pf(expf(-fabsf(z)));
    dec[idx] = expf(ls / 16.f);
}
__global__ void k_gla(const float* proj, const float* dec, float* ymix) {
    const int b = blockIdx.x >> 2, h = blockIdx.x & 3, v = threadIdx.x;
    float S[64];
#pragma unroll
    for (int d = 0; d < 64; ++d) S[d] = 0.f;
    for (int p = 0; p < NMETA + SEQ; ++p) {
        int r = p < NMETA ? p : NMETA + b * SEQ + (p - NMETA);
        const float* pr = proj + (size_t)r * INC; const float* a = dec + (size_t)r * 256 + h * 64;
        float vv = pr[C_V + h * 128 + v]; float o = 0.f;
#pragma unroll
        for (int d = 0; d < 64; ++d) { S[d] = a[d] * S[d] + pr[C_K + h * 64 + d] * vv; o += pr[C_Q + h * 64 + d] * S[d]; }
        if (p >= NMETA) ymix[(size_t)(r - NMETA) * D + 512 + h * 128 + v] = o * 0.125f;
    }
}
__global__ void k_glapost(const float* proj, const float* gnw, float* ymix) {
    int m = blockIdx.x >> 2, h = blockIdx.x & 3, v = threadIdx.x;
    float o = ymix[(size_t)m * D + 512 + h * 128 + v];
    __shared__ float red[128]; red[v] = o * o; __syncthreads();
    for (int s = 64; s > 0; s >>= 1) { if (v < s) red[v] += red[v + s]; __syncthreads(); }
    float rs = rsqrtf(red[0] / 128.f + EPS);
    float rr = proj[(size_t)(NMETA + m) * INC + C_R + h * 128 + v];
    ymix[(size_t)m * D + 512 + h * 128 + v] = o * rs * gnw[v] * (rr / (1.f + expf(-rr)));
}
__global__ void k_moe(float* out, const float* nfw, const float* wrg, const float* brg, const float* wre, const float* bre,
                      const float* wg, const float* wu, const float* wd, const float* fnw) {
    const int m = blockIdx.x, t = threadIdx.x;
    __shared__ float xn[1024], red[256], lg[20], hh[256], wsel[2]; __shared__ int esel[2];
    float* row = out + (size_t)m * D;
    float hv[4]; float s = 0.f;
    for (int i = 0; i < 4; ++i) { hv[i] = row[t + 256 * i]; s += hv[i] * hv[i]; }
    red[t] = s; __syncthreads();
    for (int o = 128; o > 0; o >>= 1) { if (t < o) red[t] += red[t + o]; __syncthreads(); }
    float rs = rsqrtf(red[0] / D + EPS); __syncthreads();
    for (int i = 0; i < 4; ++i) xn[t + 256 * i] = hv[i] * rs * nfw[t + 256 * i];
    __syncthreads();
    if (t < 20) { float a = 0.f;
        if (t < 4) { for (int k = 0; k < D; ++k) a += xn[k] * wrg[k * 4 + t]; a += brg[t]; }
        else { int e = t - 4; for (int k = 0; k < D; ++k) a += xn[k] * wre[k * 16 + e]; a += bre[e]; }
        lg[t] = a; }
    __syncthreads();
    if (t == 0) {
        int g = 0; for (int i = 1; i < 4; ++i) if (lg[i] > lg[g]) g = i;
        float mx = lg[g], den = 0.f; for (int i = 0; i < 4; ++i) den += expf(lg[i] - mx);
        float pg = 1.f / den;
        const float* el = lg + 4 + 4 * g;
        int i1 = 0; for (int i = 1; i < 4; ++i) if (el[i] > el[i1]) i1 = i;
        int i2 = -1; for (int i = 0; i < 4; ++i) if (i != i1 && (i2 < 0 || el[i] > el[i2])) i2 = i;
        float p1 = 1.f / (1.f + expf(el[i2] - el[i1])), p2 = 1.f - p1;
        esel[0] = g * 4 + i1; esel[1] = g * 4 + i2; wsel[0] = pg * p1; wsel[1] = pg * p2;
    }
    __syncthreads();
    float y[4] = {0.f, 0.f, 0.f, 0.f};
    for (int q = 0; q < 2; ++q) {
        const int e = esel[q]; const float we = wsel[q];
        const float* G = wg + (size_t)e * D * 256; const float* U = wu + (size_t)e * D * 256; const float* Dn = wd + (size_t)e * 256 * D;
        float a = 0.f, b = 0.f;
        for (int k = 0; k < D; ++k) { float xv = xn[k]; a += xv * G[(size_t)k * 256 + t]; b += xv * U[(size_t)k * 256 + t]; }
        __syncthreads();
        hh[t] = (a / (1.f + expf(-a))) * b;
        __syncthreads();
        for (int i = 0; i < 4; ++i) { float acc = 0.f; int c = t + 256 * i; for (int j = 0; j < 256; ++j) acc += hh[j] * Dn[(size_t)j * D + c]; y[i] += we * acc; }
    }
    s = 0.f; for (int i = 0; i < 4; ++i) { hv[i] += y[i]; s += hv[i] * hv[i]; }
    __syncthreads(); red[t] = s; __syncthreads();
    for (int o = 128; o > 0; o >>= 1) { if (t < o) red[t] += red[t + o]; __syncthreads(); }
    rs = rsqrtf(red[0] / D + EPS);
    for (int i = 0; i < 4; ++i) row[t + 256 * i] = hv[i] * rs * fnw[t + 256 * i];
}

extern "C" void kernel_launch(void* const* d_in, const int* in_sizes, int n_in, void* d_out, int out_size, void* d_ws, size_t ws_size, hipStream_t stream) {
    const float* x = (const float*)d_in[0]; const float* meta = (const float*)d_in[1]; const float* nmw = (const float*)d_in[2];
    const float* w_in = (const float*)d_in[3]; const float* wgu = (const float*)d_in[4]; const float* bg = (const float*)d_in[5];
    const float* gnw = (const float*)d_in[6]; const float* pool_w = (const float*)d_in[7]; const float* pool_scale = (const float*)d_in[8];
    const float* w_out = (const float*)d_in[9]; const float* nfw = (const float*)d_in[10]; const float* wrg = (const float*)d_in[11];
    const float* brg = (const float*)d_in[12]; const float* wre = (const float*)d_in[13]; const float* bre = (const float*)d_in[14];
    const float* weg = (const float*)d_in[15]; const float* weu = (const float*)d_in[16]; const float* wed = (const float*)d_in[17];
    const float* fnw = (const float*)d_in[18];
    float* out = (float*)d_out;
    char* ws = (char*)d_ws;
    size_t off = 0;
    float* proj = (float*)(ws + off); off += (size_t)R * INC * 4; off = (off + 255) & ~(size_t)255;
    float* ymix = (float*)(ws + off); off += (size_t)TR * D * 4;
    float* dec = (float*)(ws + off); off += (size_t)R * 256 * 4; off = (off + 255) & ~(size_t)255;
    float* pooled = (float*)(ws + off); off += (size_t)TR * 512 * 4;
    float* rstd = (float*)(ws + off); off += (size_t)R * 4;
    if (off > ws_size) { fprintf(stderr, "ws too small: need %zu have %zu\n", off, ws_size); return; }

    k_rstd<<<R, 256, 0, stream>>>(x, meta, rstd);
    k_gemm<1><<<dim3((INC + 63) / 64, (R + 63) / 64), 256, 0, stream>>>(x, meta, nmw, rstd, w_in, proj, R, INC, D);
    k_pooled<<<(TR * 512) / 256, 256, 0, stream>>>(proj, pooled);
    k_poolmix<<<(TR * 512) / 256, 256, 0, stream>>>(pooled, pool_w, pool_scale, ymix);
    k_decay<<<(R * 256 + 255) / 256, 256, 0, stream>>>(proj, wgu, bg, dec);
    k_gla<<<16, 128, 0, stream>>>(proj, dec, ymix);
    k_glapost<<<TR * 4, 128, 0, stream>>>(proj, gnw, ymix);
    k_gemm<2><<<dim3(D / 64, TR / 64), 256, 0, stream>>>(ymix, x, nullptr, nullptr, w_out, out, TR, D, D);
    k_moe<<<TR, 256, 0, stream>>>(out, nfw, wrg, brg, wre, bre, weg, weu, wed, fnw);
}
```

```cpp
#include <hip/hip_runtime.h>
#include <cstdio>
#include <cstdint>

constexpr int D = 1024, BATCH = 4, SEQ = 8192, NMETA = 16;
constexpr int TR = BATCH * SEQ;
constexpr int R = NMETA + TR;
constexpr int INC = 2064;
constexpr int PC = 2048;
constexpr int C_POOL = 0, C_Q = 512, C_K = 768, C_V = 1024, C_R = 1536, C_G = 2048;
constexpr float EPS = 1e-6f;
constexpr int NEXP = 16, EH = 256;

constexpr size_t MiB = 1u << 20;
constexpr size_t WS_CTL = 0, CTL_ZERO_BYTES = 1 * MiB;
constexpr size_t WS_WIN = 2 * MiB;
constexpr size_t WS_WOUT = 6 * MiB;
constexpr size_t WS_POOLW = 8 * MiB;
constexpr size_t WS_WGU = 9 * MiB;
constexpr size_t WS_WD = 25 * MiB;
constexpr size_t WS_RSTD1 = 33 * MiB;
constexpr size_t WS_MPROJ = 33 * MiB + 256 * 1024;
constexpr size_t WS_GLR = 34 * MiB;
constexpr size_t WS_ROUTE = 37 * MiB;
constexpr size_t WS_A0 = 48 * MiB;
constexpr size_t WS_PROJ = 112 * MiB;
constexpr size_t WS_YMIX = 240 * MiB;
constexpr size_t WS_DS = 304 * MiB;
constexpr size_t WS_SS = 340 * MiB;
constexpr size_t WS_XS = 376 * MiB;
constexpr size_t WS_H = 456 * MiB;
constexpr size_t WS_END = 496 * MiB;
constexpr size_t WSN_YMIX = 240 * MiB;
constexpr size_t WSN_POOLED = 376 * MiB;
constexpr size_t WSN_DEC = 456 * MiB;

#define GAS __attribute__((address_space(1)))
#define LAS __attribute__((address_space(3)))
typedef unsigned short bf16;
typedef unsigned v4u __attribute__((ext_vector_type(4)));
typedef float f32x4 __attribute__((ext_vector_type(4)));
typedef GAS unsigned gu32;
#define RLX_AGENT __ATOMIC_RELAXED, __HIP_MEMORY_SCOPE_AGENT
#define LDS_WAIT() asm volatile("s_waitcnt lgkmcnt(0)" ::: "memory")
#define VM_WAIT() asm volatile("s_waitcnt vmcnt(0)" ::: "memory")
__device__ __forceinline__ unsigned f2bf(float f) { unsigned u = __builtin_bit_cast(unsigned, f); return (u + 0x7fffu + ((u >> 16) & 1u)) >> 16; }
__device__ __forceinline__ unsigned pk2(float lo, float hi) { return f2bf(lo) | (f2bf(hi) << 16); }
__device__ __forceinline__ float bf2f(bf16 b) { return __uint_as_float((unsigned)b << 16); }
__device__ __forceinline__ float wave_sum(float v) {
#pragma unroll
    for (int o = 1; o < 64; o <<= 1) v += __shfl_xor(v, o);
    return v;
}

struct Args { const float* in[19]; float* out; unsigned char* ws; int ph_lo, ph_hi; };

namespace pg8 {
#define PG8_LAS __attribute__((address_space(3)))
typedef unsigned short bf16_t;
typedef short bf16x8 __attribute__((ext_vector_type(8)));
typedef float f32x4 __attribute__((ext_vector_type(4)));
typedef unsigned u32x4 __attribute__((ext_vector_type(4)));
constexpr int BM = 256, BK = 64, HALF = 128, HTB = HALF * BK * 2  , STAGE_BYTES = 8 * HTB, NXCD = 8, WGM = 8;

__host__ __device__ __forceinline__ int lds_byte(int r, int c) { const int st = (r >> 4) * 2 + (c >> 5), rr = r & 15, cc = c & 31, ob = rr * 64 + cc * 2; return st * 1024 + (ob ^ (((ob >> 9) & 1) << 5)); }
__host__ __device__ __forceinline__ void stage_rc(int b, int& R, int& C) { const int st = b / 1024, sb = b % 1024, swz = sb ^ (((sb >> 9) & 1) << 5); R = (st >> 1) * 16 + swz / 64; C = (st & 1) * 32 + (swz % 64) / 2; }
__host__ __device__ __forceinline__ int perm32(int rho) { const int n = rho >> 4, i = rho & 15; return 8 * (i >> 2) + 4 * n + (i & 3); }

struct Unit { int pm, pn; };
struct Gemm { const bf16_t* A; const bf16_t* Bt; int M, N, K; };

struct StaticOrder {
    int nM, nN, nwg, G, c;
    __host__ __device__ void init(int M, int N, int G_, int c_) { nM = M / BM; nN = N / BM; nwg = nM * nN; G = G_; c = c_; }
    __host__ __device__ bool next(int i, Unit& u) const {
        const long L = (long)i * G + c; if (L >= nwg) return false;
        int wgid = (int)L; { const int q = nwg / NXCD, r = nwg % NXCD, xcd = wgid % NXCD, off = wgid / NXCD; wgid = (xcd < r ? xcd * (q + 1) : r * (q + 1) + (xcd - r) * q) + off; }
        const int nig = WGM * nN, gid = wgid / nig, fm = gid * WGM, gsz = (nM - fm) < WGM ? (nM - fm) : WGM;
        u.pm = fm + ((wgid % nig) % gsz); u.pn = (wgid % nig) / gsz; return true;
    }
    __device__ __forceinline__ void a_ready(const Unit&) const {}
    __device__ __forceinline__ void done(const Unit&) const {}
};
__device__ __forceinline__ unsigned cvt_pk_bf16(float lo, float hi) { unsigned r; asm volatile("v_cvt_pk_bf16_f32 %0, %1, %2" : "=v"(r) : "v"(lo), "v"(hi)); return r; }
typedef float f32x2 __attribute__((ext_vector_type(2)));
template <class Epi, class Sched, bool ALIGN_EPI = false, bool SP2 = false>
__device__ __forceinline__ void gemm_phase(PG8_LAS unsigned char* lds, const Gemm g, const Sched& S, const Epi& E) {
    const int tid = threadIdx.x, wid = __builtin_amdgcn_readfirstlane(tid >> 6), lane = tid & 63, wr = wid >> 2, wc = wid & 3, fr = lane & 15, fq = lane >> 4;
    const int K = g.K, nt = K / BK;
    unsigned voffA[2], voffB[2];
#pragma unroll
    for (int i = 0; i < 2; ++i) { int R, C; stage_rc(tid * 16 + i * 8192, R, C); const int Rb = Epi::PERM ? ((R & ~31) + perm32(R & 31)) : R;
        voffA[i] = (unsigned)(R * K + C) * 2u; voffB[i] = (unsigned)(Rb * K + C) * 2u; }
    const size_t kstep = (size_t)(BK * 2);
    const size_t hstep = (size_t)HALF * K * 2;
    const size_t tstep = 2 * hstep;
    const unsigned ldsw = (unsigned)wid * 1024u;
    const int aoff = lds_byte(wr * 64 + fr, fq * 8), boff = lds_byte(wc * 32 + fr, fq * 8);
#define PG8_SA(b, h) (((b) * 2 + (h)) * HTB)
#define PG8_SB(b, h) ((4 + (b) * 2 + (h)) * HTB)
#define PG8_STAGE(bufoff, gbase, voff) do { _Pragma("unroll") for (int _i = 0; _i < 2; ++_i) \
        __builtin_amdgcn_global_load_lds((const unsigned*)((const char*)(gbase) + (voff)[_i]), (PG8_LAS unsigned*)(lds + (bufoff) + ldsw + _i * 8192), 16, 0, 0); } while (0)
#define PG8_LDA(dst, b, h) do { _Pragma("unroll") for (int m = 0; m < 4; ++m) _Pragma("unroll") for (int k = 0; k < 2; ++k) dst[m][k] = *(const PG8_LAS bf16x8*)(lds + PG8_SA(b, h) + aoff + m * 2048 + k * 1024); } while (0)
#define PG8_LDB(dst, b, h) do { _Pragma("unroll") for (int n = 0; n < 2; ++n) _Pragma("unroll") for (int k = 0; k < 2; ++k) dst[n][k] = *(const PG8_LAS bf16x8*)(lds + PG8_SB(b, h) + boff + n * 2048 + k * 1024); } while (0)
#define PG8_MMA(ai, bj, At, Bt) do { __builtin_amdgcn_s_setprio(1); _Pragma("unroll") for (int m = 0; m < 4; ++m) _Pragma("unroll") for (int n = 0; n < 2; ++n) _Pragma("unroll") for (int k = 0; k < 2; ++k) \
        acc[ai][bj][m][n] = __builtin_amdgcn_mfma_f32_16x16x32_bf16(Bt[n][k], At[m][k], acc[ai][bj][m][n], 0, 0, 0); __builtin_amdgcn_s_setprio(0); } while (0)
#define PG8_WAIT_V(n) asm volatile("s_waitcnt vmcnt(" #n ")" ::: "memory")
#define PG8_WAIT_L(n) asm volatile("s_waitcnt lgkmcnt(" #n ")" ::: "memory")
#define PG8_BAR __builtin_amdgcn_s_barrier()
#define PG8_SCHED __builtin_amdgcn_sched_barrier(0)
    Unit cur, nxt; int ui = 0;
    if (!S.next(0, cur)) return;
    f32x4 acc[2][2][4][2];
#pragma unroll
    for (int a = 0; a < 2; ++a)
#pragma unroll
        for (int b = 0; b < 2; ++b)
#pragma unroll
            for (int m = 0; m < 4; ++m)
#pragma unroll
                for (int n = 0; n < 2; ++n) acc[a][b][m][n] = (f32x4){0.f, 0.f, 0.f, 0.f};
    bf16x8 At[4][2], B0[2][2], B1[2][2];
    const char* cA = (const char*)g.A + (size_t)cur.pm * tstep; const char* cB = (const char*)g.Bt + (size_t)cur.pn * tstep;
    S.a_ready(cur);
    if constexpr (SP2) {
        PG8_STAGE(PG8_SB(0, 0), cB, voffB); PG8_STAGE(PG8_SB(0, 1), cB + hstep, voffB); PG8_STAGE(PG8_SA(0, 0), cA, voffA); PG8_STAGE(PG8_SA(0, 1), cA + hstep, voffA);
        if (wr == 1) PG8_BAR;
        PG8_WAIT_V(2); PG8_BAR;
        PG8_STAGE(PG8_SB(1, 0), cB + kstep, voffB); PG8_STAGE(PG8_SA(1, 0), cA + kstep, voffA); PG8_STAGE(PG8_SB(1, 1), cB + hstep + kstep, voffB);
        PG8_WAIT_V(6); PG8_BAR;
    } else {
        PG8_STAGE(PG8_SB(0, 0), cB, voffB); PG8_STAGE(PG8_SA(0, 0), cA, voffA); PG8_STAGE(PG8_SB(0, 1), cB + hstep, voffB); PG8_STAGE(PG8_SA(0, 1), cA + hstep, voffA);
        if (wr == 1) PG8_BAR;
        PG8_WAIT_V(4); PG8_BAR;
        PG8_STAGE(PG8_SB(1, 0), cB + kstep, voffB); PG8_STAGE(PG8_SA(1, 0), cA + kstep, voffA); PG8_STAGE(PG8_SB(1, 1), cB + hstep + kstep, voffB);
        PG8_WAIT_V(6); PG8_BAR;
    }
    for (;;) {
        const bool has_next = S.next(ui + 1, nxt);
        const char* nA = has_next ? (const char*)g.A + (size_t)nxt.pm * tstep : cA; const char* nB = has_next ? (const char*)g.Bt + (size_t)nxt.pn * tstep : cB;
        for (int t = 0; t < nt; t += 2) {
            const bool last = (t == nt - 2);
            const char* a1 = cA + (size_t)(t + 1) * kstep;
            const char* a2 = last ? nA : cA + (size_t)(t + 2) * kstep; const char* b2 = last ? nB : cB + (size_t)(t + 2) * kstep;
            const char* a3 = a2 + kstep; const char* b3 = b2 + kstep;
            if (last && has_next) S.a_ready(nxt);
            if constexpr (SP2) {
            PG8_LDB(B0, 0, 0); PG8_LDB(B1, 0, 1); PG8_SCHED; PG8_LDA(At, 0, 0); PG8_STAGE(PG8_SA(1, 1), a1 + hstep, voffA);
            PG8_WAIT_V(8); PG8_WAIT_L(0); PG8_BAR; PG8_MMA(0, 0, At, B0); PG8_MMA(0, 1, At, B1); PG8_BAR; PG8_SCHED;
            PG8_LDA(At, 0, 1); PG8_STAGE(PG8_SB(0, 0), b2, voffB); PG8_STAGE(PG8_SB(0, 1), b2 + hstep, voffB); PG8_STAGE(PG8_SA(0, 0), a2, voffA);
            PG8_WAIT_V(8); PG8_WAIT_L(0); PG8_BAR; PG8_MMA(1, 0, At, B0); PG8_MMA(1, 1, At, B1); PG8_BAR; PG8_SCHED;
            PG8_LDB(B0, 1, 0); PG8_LDB(B1, 1, 1); PG8_SCHED; PG8_LDA(At, 1, 0); PG8_STAGE(PG8_SA(0, 1), a2 + hstep, voffA);
            PG8_WAIT_V(8); PG8_WAIT_L(0); PG8_BAR; PG8_MMA(0, 0, At, B0); PG8_MMA(0, 1, At, B1); PG8_BAR; PG8_SCHED;
            PG8_LDA(At, 1, 1); PG8_STAGE(PG8_SB(1, 0), b3, voffB); PG8_STAGE(PG8_SB(1, 1), b3 + hstep, voffB); PG8_STAGE(PG8_SA(1, 0), a3, voffA);
            PG8_WAIT_V(8); PG8_WAIT_L(0); PG8_BAR; PG8_MMA(1, 0, At, B0); PG8_MMA(1, 1, At, B1); PG8_BAR; PG8_SCHED;
            } else {
            PG8_LDB(B0, 0, 0); PG8_SCHED; PG8_LDA(At, 0, 0); PG8_STAGE(PG8_SA(1, 1), a1 + hstep, voffA);
            PG8_WAIT_L(8); PG8_BAR; PG8_WAIT_L(0); PG8_MMA(0, 0, At, B0); PG8_BAR; PG8_SCHED;
            PG8_LDB(B1, 0, 1); PG8_STAGE(PG8_SB(0, 0), b2, voffB);
            PG8_BAR; PG8_WAIT_L(0); PG8_MMA(0, 1, At, B1); PG8_BAR;
            PG8_LDA(At, 0, 1); PG8_STAGE(PG8_SA(0, 0), a2, voffA);
            PG8_BAR; PG8_WAIT_L(0); PG8_MMA(1, 0, At, B0); PG8_BAR; PG8_SCHED;
            PG8_STAGE(PG8_SB(0, 1), b2 + hstep, voffB);
            PG8_WAIT_V(6); PG8_BAR; PG8_MMA(1, 1, At, B1); PG8_BAR;
            PG8_LDB(B0, 1, 0); PG8_SCHED; PG8_LDA(At, 1, 0); PG8_STAGE(PG8_SA(0, 1), a2 + hstep, voffA);
            PG8_WAIT_L(8); PG8_BAR; PG8_WAIT_L(0); PG8_MMA(0, 0, At, B0); PG8_BAR; PG8_SCHED;
            PG8_LDB(B1, 1, 1); PG8_STAGE(PG8_SB(1, 0), b3, voffB);
            PG8_BAR; PG8_WAIT_L(0); PG8_MMA(0, 1, At, B1); PG8_BAR;
            PG8_LDA(At, 1, 1); PG8_STAGE(PG8_SA(1, 0), a3, voffA);
            PG8_BAR; PG8_WAIT_L(0); PG8_MMA(1, 0, At, B0); PG8_BAR; PG8_SCHED;
            PG8_STAGE(PG8_SB(1, 1), b3 + hstep, voffB);
            PG8_WAIT_V(6); PG8_BAR; PG8_MMA(1, 1, At, B1); PG8_BAR;
            }
        }
        if constexpr (ALIGN_EPI) { if (wr == 0) PG8_BAR; }
        if constexpr (!Epi::AFTER_DRAIN) { E(acc, cur, wr, wc, fr, fq); S.done(cur); }
        if (!has_next) break;
#pragma unroll
        for (int a = 0; a < 2; ++a)
#pragma unroll
            for (int b = 0; b < 2; ++b)
#pragma unroll
                for (int m = 0; m < 4; ++m)
#pragma unroll
                    for (int n = 0; n < 2; ++n) acc[a][b][m][n] = (f32x4){0.f, 0.f, 0.f, 0.f};
        cur = nxt; cA = nA; cB = nB; ++ui;
        if constexpr (ALIGN_EPI) { if (wr == 1) PG8_BAR; }
    }
    PG8_WAIT_V(0);
    if constexpr (!ALIGN_EPI) { if (wr == 0) PG8_BAR; }
    PG8_BAR;
    if constexpr (Epi::AFTER_DRAIN) { E.fused(acc, cur, wr, wc, fr, fq, lds, wid, lane); S.done(cur); }
#undef PG8_SA
#undef PG8_SB
#undef PG8_STAGE
#undef PG8_LDA
#undef PG8_LDB
#undef PG8_MMA
#undef PG8_WAIT_V
#undef PG8_WAIT_L
#undef PG8_BAR
#undef PG8_SCHED
}
struct EpiRowScaleBf16 {
    static constexpr bool PERM = true, AFTER_DRAIN = false;
    bf16_t* O; int ldc; const float* rs;
    __device__ __forceinline__ void operator()(const f32x4 (&acc)[2][2][4][2], const Unit& u, int wr, int wc, int fr, int fq) const {
        const int row0 = u.pm * BM + wr * 64 + fr, col0 = u.pn * BM + wc * 32 + 8 * fq;
#pragma unroll
        for (int ai = 0; ai < 2; ++ai)
#pragma unroll
            for (int m = 0; m < 4; ++m) { const int row = row0 + ai * HALF + m * 16; const float s = rs[row]; bf16_t* rowp = O + (size_t)row * ldc + col0;
#pragma unroll
                for (int bj = 0; bj < 2; ++bj) { const f32x4 v0 = acc[ai][bj][m][0] * s, v1 = acc[ai][bj][m][1] * s;
                    u32x4 w; w.x = cvt_pk_bf16(v0[0], v0[1]); w.y = cvt_pk_bf16(v0[2], v0[3]); w.z = cvt_pk_bf16(v1[0], v1[1]); w.w = cvt_pk_bf16(v1[2], v1[3]);
                    *(u32x4*)(rowp + bj * HALF) = w; } }
    }
};
}
#define PG8_SP2 true
#define PG8_ALIGN true
#define XB_TMO      128
#define XB_XCNT(j)  (256  + 64 * (j))
#define XB_XSUB(j)  (1280 + 64 * (j))
#define XB_XGEN(j)  (2304 + 64 * (j))
#define XB_TOP      3328
#define XB_TOPGEN   3392
#define XCD_BAR_WORDS 3456
#define XB_SPIN_CAP (1u << 18)

__device__ __forceinline__ unsigned xb_ld(unsigned* p)              { return __hip_atomic_load(p, __ATOMIC_RELAXED, __HIP_MEMORY_SCOPE_AGENT); }
__device__ __forceinline__ unsigned xb_add(unsigned* p, unsigned v) { return __hip_atomic_fetch_add(p, v, __ATOMIC_RELAXED, __HIP_MEMORY_SCOPE_AGENT); }
__device__ __forceinline__ unsigned xb_xcc_id() { return (unsigned)__builtin_amdgcn_s_getreg((3 << 11) | 20) & 0xFu; }
#define XB_SPIN(cond, bar) do { unsigned _sp = 0; while (cond) { __builtin_amdgcn_s_sleep(1); \
    if ((++_sp & 255u) == 0u) { if (xb_ld(&(bar)[XB_TMO])) break; if (_sp > XB_SPIN_CAP) { atomicAdd(&(bar)[XB_TMO], 1u); break; } } } } while (0)

struct XcdBarrier {
    unsigned* bar; unsigned x;
    volatile LAS unsigned* st;
};

__device__ __forceinline__ XcdBarrier xcd_barrier_post(unsigned* bar, volatile LAS unsigned* st) {
    XcdBarrier b; b.bar = bar; b.x = xb_xcc_id(); b.st = st;
    if (threadIdx.x == 0) (void)xb_add(&bar[XB_XCNT(b.x)], 1u);
    return b;
}
__device__ __forceinline__ void xcd_barrier_complete(unsigned* bar, unsigned x, unsigned& nloc, unsigned& nx) {
    const unsigned G = gridDim.x * gridDim.y * gridDim.z;
    unsigned sum, cnt, mine, sp = 0u;
    for (;;) {
        sum = 0u; cnt = 0u; mine = 0u;
#pragma unroll
        for (unsigned j = 0; j < 16; ++j) { const unsigned c = xb_ld(&bar[XB_XCNT(j)]); sum += c; cnt += (c > 0u) ? 1u : 0u; mine = (j == x) ? c : mine; }
        if (sum == G) break;
        __builtin_amdgcn_s_sleep(1);
        if ((++sp & 255u) == 0u) { if (xb_ld(&bar[XB_TMO])) break; if (sp > XB_SPIN_CAP) { atomicAdd(&bar[XB_TMO], 1u); break; } }
    }
    nloc = mine > 0u ? mine : 1u; nx = cnt > 0u ? cnt : 1u;
}

__device__ __forceinline__ void xcd_barrier(const XcdBarrier& b) {
    asm volatile("s_waitcnt vmcnt(0)" ::: "memory");
    __syncthreads();
    if (threadIdx.x == 0) {
        unsigned* bar = b.bar;
        __builtin_amdgcn_s_waitcnt(0);
        unsigned nloc = b.st[0], nx = b.st[1];
        if (nloc == 0u) { xcd_barrier_complete(bar, b.x, nloc, nx); b.st[0] = nloc; b.st[1] = nx; }
        const unsigned old = xb_add(&bar[XB_XSUB(b.x)], 1u);
        const unsigned gen = old / nloc;
        if (old + 1u == (gen + 1u) * nloc) {
            __builtin_amdgcn_fence(__ATOMIC_RELEASE, "agent");
            asm volatile("s_waitcnt vmcnt(0)" ::: "memory");
            const unsigned og = xb_add(&bar[XB_TOP], 1u);
            const unsigned tg = og / nx;
            if (og + 1u == (tg + 1u) * nx) xb_add(&bar[XB_TOPGEN], 1u);
            else XB_SPIN(xb_ld(&bar[XB_TOPGEN]) == tg, bar);
            __builtin_amdgcn_fence(__ATOMIC_ACQUIRE, "agent");
            xb_add(&bar[XB_XGEN(b.x)], 1u);
            asm volatile("s_waitcnt vmcnt(0)" ::: "memory");
        } else {
            XB_SPIN(xb_ld(&bar[XB_XGEN(b.x)]) == gen, bar);
            __builtin_amdgcn_fence(__ATOMIC_ACQUIRE, "agent");
            asm volatile("s_waitcnt vmcnt(0)" ::: "memory");
        }
    }
    __syncthreads();
}
typedef short s16x8 __attribute__((ext_vector_type(8)));
typedef float f32x16 __attribute__((ext_vector_type(16)));
typedef unsigned u32x2 __attribute__((ext_vector_type(2)));
__device__ __forceinline__ f32x16 mfma32(s16x8 a, s16x8 b, f32x16 c) { return __builtin_amdgcn_mfma_f32_32x32x16_bf16(a, b, c, 0, 0, 0); }
__device__ __forceinline__ s16x8 pack8(float a0, float a1, float a2, float a3, float a4, float a5, float a6, float a7) {
    v4u w; w.x = pk2(a0, a1); w.y = pk2(a2, a3); w.z = pk2(a4, a5); w.w = pk2(a6, a7); return __builtin_bit_cast(s16x8, w); }
__device__ __forceinline__ int rho(int t, int h2, int j) { return 16 * t + 8 * (j >> 2) + 4 * h2 + (j & 3); }

constexpr size_t DS_UNIT = 128 * 64;
constexpr size_t WS_DECAY = WS_DS + (size_t)16 * 128 * DS_UNIT * 2;
constexpr size_t WS_DSMETA = WS_DECAY + (size_t)16 * 128 * 64 * 4;
static_assert(WS_DSMETA + 4 * DS_UNIT * 4 <= WS_SS, "ds region");
static_assert(WS_SS + (size_t)16 * 128 * DS_UNIT * 2 <= WS_XS, "ss region");

__device__ __forceinline__ void gla_gate(const float* glr_rows, const float* wgu, const float* bg, int h, int lane, s16x8 (&laH)[2][2][2], s16x8 (&laL)[2][2][2]) {
    const int l31 = lane & 31, h2 = lane >> 5;
    s16x8 Wf[2];
#pragma unroll
    for (int Db = 0; Db < 2; ++Db) { const float* wp = wgu + (8 * h2) * 256 + h * 64 + 32 * Db + l31;
        Wf[Db] = pack8(wp[0], wp[256], wp[512], wp[768], wp[1024], wp[1280], wp[1536], wp[1792]); }
#pragma unroll
    for (int T = 0; T < 2; ++T) {
        const f32x4* gp = (const f32x4*)(glr_rows + (32 * T + l31) * 16 + 8 * h2); const f32x4 g0 = gp[0], g1 = gp[1];
        const s16x8 Gf = pack8(g0.x, g0.y, g0.z, g0.w, g1.x, g1.y, g1.z, g1.w);
#pragma unroll
        for (int Db = 0; Db < 2; ++Db) {
            const float bias = bg[h * 64 + 32 * Db + l31]; f32x16 acc;
#pragma unroll
            for (int r = 0; r < 16; ++r) acc[r] = bias;
            acc = mfma32(Gf, Wf[Db], acc);
            float hi[16], lo[16];
#pragma unroll
            for (int r = 0; r < 16; ++r) { const float z = acc[r]; const float la = (fminf(z, 0.f) - __logf(1.f + __expf(-fabsf(z)))) * 0.0625f;
                const float hf = __uint_as_float(f2bf(la) << 16); hi[r] = hf; lo[r] = la - hf; }
#pragma unroll
            for (int t = 0; t < 2; ++t) { laH[T][Db][t] = pack8(hi[8 * t], hi[8 * t + 1], hi[8 * t + 2], hi[8 * t + 3], hi[8 * t + 4], hi[8 * t + 5], hi[8 * t + 6], hi[8 * t + 7]);
                                          laL[T][Db][t] = pack8(lo[8 * t], lo[8 * t + 1], lo[8 * t + 2], lo[8 * t + 3], lo[8 * t + 4], lo[8 * t + 5], lo[8 * t + 6], lo[8 * t + 7]); }
        }
    }
}
__device__ __forceinline__ void tri_frags(int lane, s16x8 (&tri)[2], s16x8& ones) {
    const int l31 = lane & 31, h2 = lane >> 5;
#pragma unroll
    for (int t = 0; t < 2; ++t) { s16x8 f;
#pragma unroll
        for (int j = 0; j < 8; ++j) f[j] = (rho(t, h2, j) <= l31) ? (short)0x3F80 : (short)0;
        tri[t] = f; }
#pragma unroll
    for (int j = 0; j < 8; ++j) ones[j] = (short)0x3F80;
}
__device__ __forceinline__ s16x8 load_vfrag(const bf16* vcol, int T, int t, int h2) {
    s16x8 f;
#pragma unroll
    for (int j = 0; j < 8; ++j) f[j] = (short)vcol[(size_t)(32 * T + rho(t, h2, j)) * PC];
    return f;
}

__device__ __forceinline__ void gla_pass1_unit(const Args& a, int unit, int lane) {
    unsigned char* ws = a.ws;
    const int bh = unit >> 7, nm1 = unit & 127, b = bh >> 2, h = bh & 3, l31 = lane & 31, h2 = lane >> 5;
    const int m0 = b * SEQ + 64 * nm1;
    const bf16* proj = (const bf16*)(ws + WS_PROJ);
    s16x8 laH[2][2][2], laL[2][2][2];
    gla_gate((const float*)(ws + WS_GLR) + (size_t)m0 * 16, a.in[4], a.in[5], h, lane, laH, laL);
    s16x8 tri[2], ones; tri_frags(lane, tri, ones);
    f32x16 bA[2][2];
#pragma unroll
    for (int T = 0; T < 2; ++T)
#pragma unroll
        for (int Db = 0; Db < 2; ++Db) { f32x16 acc;
#pragma unroll
            for (int r = 0; r < 16; ++r) acc[r] = 0.f;
#pragma unroll
            for (int Ts = 0; Ts <= T; ++Ts)
#pragma unroll
                for (int t = 0; t < 2; ++t) { const s16x8 Lf = (Ts == T) ? tri[t] : ones; acc = mfma32(Lf, laH[Ts][Db][t], acc); acc = mfma32(Lf, laL[Ts][Db][t], acc); }
            bA[T][Db] = acc; }
    float blast[2];
#pragma unroll
    for (int Db = 0; Db < 2; ++Db) blast[Db] = __shfl(bA[1][Db][15], l31 + 32);
    if (h2 == 0) { float* dec = (float*)(ws + WS_DECAY) + (size_t)unit * 64; dec[l31] = __expf(blast[0]); dec[32 + l31] = __expf(blast[1]); }
    s16x8 ke[2][2][2];
#pragma unroll
    for (int Db = 0; Db < 2; ++Db) { const bf16* kcol = proj + (size_t)m0 * PC + C_K + h * 64 + 32 * Db + l31;
#pragma unroll
        for (int T = 0; T < 2; ++T)
#pragma unroll
            for (int t = 0; t < 2; ++t) { float kv[8];
#pragma unroll
                for (int j = 0; j < 8; ++j) kv[j] = bf2f(kcol[(size_t)(32 * T + rho(t, h2, j)) * PC]) * __expf(blast[Db] - bA[T][Db][8 * t + j]);
                ke[Db][T][t] = pack8(kv[0], kv[1], kv[2], kv[3], kv[4], kv[5], kv[6], kv[7]); } }
    bf16* dS = (bf16*)(ws + WS_DS) + (size_t)unit * DS_UNIT;
#pragma unroll 1
    for (int Vb = 0; Vb < 4; ++Vb) {
        const bf16* vcol = proj + (size_t)m0 * PC + C_V + h * 128 + 32 * Vb + l31;
        f32x16 acc0, acc1;
#pragma unroll
        for (int r = 0; r < 16; ++r) { acc0[r] = 0.f; acc1[r] = 0.f; }
#pragma unroll
        for (int T = 0; T < 2; ++T)
#pragma unroll
            for (int t = 0; t < 2; ++t) { const s16x8 Vf = load_vfrag(vcol, T, t, h2); acc0 = mfma32(ke[0][T][t], Vf, acc0); acc1 = mfma32(ke[1][T][t], Vf, acc1); }
        bf16* row = dS + (size_t)(32 * Vb + l31) * 64;
#pragma unroll
        for (int i = 0; i < 4; ++i) { u32x2 w0, w1; w0.x = pk2(acc0[4 * i], acc0[4 * i + 1]); w0.y = pk2(acc0[4 * i + 2], acc0[4 * i + 3]); w1.x = pk2(acc1[4 * i], acc1[4 * i + 1]); w1.y = pk2(acc1[4 * i + 2], acc1[4 * i + 3]);
            *(u32x2*)(row + 8 * i + 4 * h2) = w0; *(u32x2*)(row + 32 + 8 * i + 4 * h2) = w1; }
    }
}
__device__ __forceinline__ void gla_meta_unit(const Args& a, int mu, int lane) {
    const int h = mu >> 3, vs = mu & 7, d = lane;
    const float* mproj = (const float*)(a.ws + WS_MPROJ); const float* wgu = a.in[4]; const float* bg = a.in[5];
    float w[16];
#pragma unroll
    for (int r = 0; r < 16; ++r) w[r] = wgu[r * 256 + h * 64 + d];
    float bs[16], run = 0.f;
#pragma unroll
    for (int s = 0; s < 16; ++s) { float z = bg[h * 64 + d];
#pragma unroll
        for (int r = 0; r < 16; ++r) z += mproj[s * INC + C_G + r] * w[r];
        run += (fminf(z, 0.f) - log1pf(expf(-fabsf(z)))) * 0.0625f; bs[s] = run; }
    float ke[16];
#pragma unroll
    for (int s = 0; s < 16; ++s) ke[s] = mproj[s * INC + C_K + h * 64 + d] * expf(bs[15] - bs[s]);
    float* out = (float*)(a.ws + WS_DSMETA) + (size_t)h * DS_UNIT;
#pragma unroll 4
    for (int vv = 0; vv < 16; ++vv) { const int v = 16 * vs + vv; float acc = 0.f;
#pragma unroll
        for (int s = 0; s < 16; ++s) acc += ke[s] * mproj[s * INC + C_V + h * 128 + v];
        out[v * 64 + d] = acc; }
}
__device__ __forceinline__ void gla_scan(const Args& a, int gtid, int gthreads) {
    unsigned char* ws = a.ws;
    for (int id = gtid; id < 16 * 128 * 16; id += gthreads) {
        const int bh = id >> 11, v = (id >> 4) & 127, d4 = (id & 15) * 4, h = bh & 3;
        const f32x4 s0 = *(const f32x4*)((const float*)(ws + WS_DSMETA) + (size_t)h * DS_UNIT + v * 64 + d4);
        float S0 = s0.x, S1 = s0.y, S2 = s0.z, S3 = s0.w;
        const bf16* dS = (const bf16*)(ws + WS_DS) + (size_t)bh * 128 * DS_UNIT + v * 64 + d4;
        bf16* SS = (bf16*)(ws + WS_SS) + (size_t)bh * 128 * DS_UNIT + v * 64 + d4;
        const float* dec = (const float*)(ws + WS_DECAY) + (size_t)bh * 128 * 64 + d4;
#pragma unroll 1
        for (int n0 = 0; n0 < 128; n0 += 16) {
            u32x2 dv[16]; f32x4 dc[16];
#pragma unroll
            for (int i = 0; i < 16; ++i) { dv[i] = *(const u32x2*)(dS + (size_t)(n0 + i) * DS_UNIT); dc[i] = *(const f32x4*)(dec + (size_t)(n0 + i) * 64); }
#pragma unroll
            for (int i = 0; i < 16; ++i) {
                u32x2 o; o.x = pk2(S0, S1); o.y = pk2(S2, S3); *(u32x2*)(SS + (size_t)(n0 + i) * DS_UNIT) = o;
                S0 = dc[i].x * S0 + __uint_as_float(dv[i].x << 16); S1 = dc[i].y * S1 + __uint_as_float(dv[i].x & 0xffff0000u);
                S2 = dc[i].z * S2 + __uint_as_float(dv[i].y << 16); S3 = dc[i].w * S3 + __uint_as_float(dv[i].y & 0xffff0000u);
            }
        }
    }
}
__device__ __forceinline__ void gla_pass2_unit(const Args& a, int unit, int lane) {
    unsigned char* ws = a.ws;
    const int bh = unit >> 7, nm1 = unit & 127, b = bh >> 2, h = bh & 3, l31 = lane & 31, h2 = lane >> 5;
    const int m0 = b * SEQ + 64 * nm1;
    const bf16* proj = (const bf16*)(ws + WS_PROJ);
    s16x8 qt[2][4], kt[2][4];
    {
        s16x8 laH[2][2][2], laL[2][2][2];
        gla_gate((const float*)(ws + WS_GLR) + (size_t)m0 * 16, a.in[4], a.in[5], h, lane, laH, laL);
        s16x8 tri[2], ones; tri_frags(lane, tri, ones);
#pragma unroll
        for (int T = 0; T < 2; ++T)
#pragma unroll
            for (int Db = 0; Db < 2; ++Db) {
                f32x16 acc;
#pragma unroll
                for (int r = 0; r < 16; ++r) acc[r] = 0.f;
#pragma unroll
                for (int Ts = 0; Ts <= T; ++Ts)
#pragma unroll
                    for (int t = 0; t < 2; ++t) { const s16x8 Uf = (Ts == T) ? tri[t] : ones; acc = mfma32(laH[Ts][Db][t], Uf, acc); acc = mfma32(laL[Ts][Db][t], Uf, acc); }
                const bf16* qrow = proj + (size_t)(m0 + 32 * T + l31) * PC + C_Q + h * 64; const bf16* krow = qrow + (C_K - C_Q);
#pragma unroll
                for (int t = 0; t < 2; ++t) { const int ks = 2 * Db + t;
                    const u32x2 q0 = *(const u32x2*)(qrow + 16 * ks + 4 * h2), q1 = *(const u32x2*)(qrow + 16 * ks + 8 + 4 * h2);
                    const u32x2 k0 = *(const u32x2*)(krow + 16 * ks + 4 * h2), k1 = *(const u32x2*)(krow + 16 * ks + 8 + 4 * h2);
                    float e[8], qf[8], kf[8];
#pragma unroll
                    for (int j = 0; j < 8; ++j) e[j] = __expf(acc[8 * t + j]);
                    qf[0] = __uint_as_float(q0.x << 16); qf[1] = __uint_as_float(q0.x & 0xffff0000u); qf[2] = __uint_as_float(q0.y << 16); qf[3] = __uint_as_float(q0.y & 0xffff0000u);
                    qf[4] = __uint_as_float(q1.x << 16); qf[5] = __uint_as_float(q1.x & 0xffff0000u); qf[6] = __uint_as_float(q1.y << 16); qf[7] = __uint_as_float(q1.y & 0xffff0000u);
                    kf[0] = __uint_as_float(k0.x << 16); kf[1] = __uint_as_float(k0.x & 0xffff0000u); kf[2] = __uint_as_float(k0.y << 16); kf[3] = __uint_as_float(k0.y & 0xffff0000u);
                    kf[4] = __uint_as_float(k1.x << 16); kf[5] = __uint_as_float(k1.x & 0xffff0000u); kf[6] = __uint_as_float(k1.y << 16); kf[7] = __uint_as_float(k1.y & 0xffff0000u);
#pragma unroll
                    for (int j = 0; j < 8; ++j) { qf[j] = qf[j] * 0.125f * e[j]; kf[j] = kf[j] * __builtin_amdgcn_rcpf(e[j]); }
                    qt[T][ks] = pack8(qf[0], qf[1], qf[2], qf[3], qf[4], qf[5], qf[6], qf[7]);
                    kt[T][ks] = pack8(kf[0], kf[1], kf[2], kf[3], kf[4], kf[5], kf[6], kf[7]); }
            }
    }
    const bf16* St = (const bf16*)(ws + WS_SS) + (size_t)unit * DS_UNIT;
    const float* gnw = a.in[6];
    bf16* ymix = (bf16*)(ws + WS_YMIX);
#pragma unroll
    for (int C = 0; C < 2; ++C) {
        f32x16 Y[4];
#pragma unroll
        for (int Vb = 0; Vb < 4; ++Vb)
#pragma unroll
            for (int r = 0; r < 16; ++r) Y[Vb][r] = 0.f;
#pragma unroll
        for (int S = 0; S < 2; ++S) {
            if (S <= C) {
                f32x16 sc;
#pragma unroll
                for (int r = 0; r < 16; ++r) sc[r] = 0.f;
#pragma unroll
                for (int ks = 0; ks < 4; ++ks) sc = mfma32(kt[S][ks], qt[C][ks], sc);
                if (S == C) {
#pragma unroll
                    for (int r = 0; r < 16; ++r) { const int sl = (r & 3) + 8 * (r >> 2) + 4 * h2; if (sl > l31) sc[r] = 0.f; }
                }
                s16x8 P[2];
#pragma unroll
                for (int t = 0; t < 2; ++t) P[t] = pack8(sc[8 * t], sc[8 * t + 1], sc[8 * t + 2], sc[8 * t + 3], sc[8 * t + 4], sc[8 * t + 5], sc[8 * t + 6], sc[8 * t + 7]);
#pragma unroll
                for (int Vb = 0; Vb < 4; ++Vb) { const bf16* vcol = proj + (size_t)m0 * PC + C_V + h * 128 + 32 * Vb + l31;
#pragma unroll
                    for (int t = 0; t < 2; ++t) { const s16x8 Vf = load_vfrag(vcol, S, t, h2); Y[Vb] = mfma32(Vf, P[t], Y[Vb]); } }
            }
        }
#pragma unroll
        for (int Vb = 0; Vb < 4; ++Vb) { const bf16* srow = St + (size_t)(32 * Vb + l31) * 64;
#pragma unroll
            for (int ks = 0; ks < 4; ++ks) { const u32x2 s0 = *(const u32x2*)(srow + 16 * ks + 4 * h2), s1 = *(const u32x2*)(srow + 16 * ks + 8 + 4 * h2);
                v4u w; w.x = s0.x; w.y = s0.y; w.z = s1.x; w.w = s1.y; Y[Vb] = mfma32(__builtin_bit_cast(s16x8, w), qt[C][ks], Y[Vb]); } }
        float ss = 0.f;
#pragma unroll
        for (int Vb = 0; Vb < 4; ++Vb)
#pragma unroll
            for (int r = 0; r < 16; ++r) ss += Y[Vb][r] * Y[Vb][r];
        ss += __shfl_xor(ss, 32);
        const float rs = rsqrtf(ss * (1.f / 128.f) + EPS);
        const int m = m0 + 32 * C + l31;
        const bf16* rrow = proj + (size_t)m * PC + C_R + h * 128; bf16* orow = ymix + (size_t)m * D + 512 + h * 128;
#pragma unroll
        for (int Vb = 0; Vb < 4; ++Vb)
#pragma unroll
            for (int i = 0; i < 4; ++i) { const int v = 32 * Vb + 8 * i + 4 * h2;
                const u32x2 rr = *(const u32x2*)(rrow + v); const f32x4 gw = *(const f32x4*)(gnw + v);
                const float r0 = __uint_as_float(rr.x << 16), r1 = __uint_as_float(rr.x & 0xffff0000u), r2 = __uint_as_float(rr.y << 16), r3 = __uint_as_float(rr.y & 0xffff0000u);
                const float o0 = Y[Vb][4 * i] * rs * gw.x * (r0 / (1.f + __expf(-r0))), o1 = Y[Vb][4 * i + 1] * rs * gw.y * (r1 / (1.f + __expf(-r1)));
                const float o2 = Y[Vb][4 * i + 2] * rs * gw.z * (r2 / (1.f + __expf(-r2))), o3 = Y[Vb][4 * i + 3] * rs * gw.w * (r3 / (1.f + __expf(-r3)));
                u32x2 w; w.x = pk2(o0, o1); w.y = pk2(o2, o3); *(u32x2*)(orow + v) = w; }
    }
}
template <int W>
__device__ __forceinline__ void pool_fill(const bf16* proj, const float* mproj, int b, int s0, int g, int lane, LAS unsigned char* tile) {
    auto ld = [&](int s, float& x0, float& x1) {
        if (s >= 0) { const unsigned u = *(const unsigned*)(proj + (size_t)(b * SEQ + s) * PC + g * 128 + 2 * lane); x0 = __uint_as_float(u << 16); x1 = __uint_as_float(u & 0xffff0000u); }
        else { const float* p = mproj + (NMETA + s) * INC + g * 128 + 2 * lane; x0 = p[0]; x1 = p[1]; } };
    float w0 = 0.f, w1 = 0.f, x0, x1;
#pragma unroll
    for (int j = 1; j < W; ++j) { ld(s0 - j, x0, x1); w0 += x0; w1 += x1; }
    constexpr float inv = 1.f / W;
#pragma unroll 4
    for (int tok = 0; tok < 64; ++tok) {
        ld(s0 + tok, x0, x1); w0 += x0; w1 += x1;
        const float p0 = w0 * inv - x0, p1 = w1 * inv - x1;
        *(LAS unsigned*)(tile + tok * 256 + ((4 * lane) ^ ((tok & 15) << 4))) = pk2(p0, p1);
        float y0, y1; ld(s0 + tok - (W - 1), y0, y1); w0 -= y0; w1 -= y1;
    }
}
__device__ __forceinline__ void pool_unit(const Args& a, int unit, int lane, LAS unsigned char* tile) {
    unsigned char* ws = a.ws;
    const int tt = unit >> 2, g = unit & 3, m0 = 64 * tt, b = m0 / SEQ, s0 = m0 % SEQ, l31 = lane & 31, h2 = lane >> 5;
    const bf16* proj = (const bf16*)(ws + WS_PROJ); const float* mproj = (const float*)(ws + WS_MPROJ);
    if (g == 0) pool_fill<2>(proj, mproj, b, s0, g, lane, tile); else if (g == 1) pool_fill<4>(proj, mproj, b, s0, g, lane, tile);
    else if (g == 2) pool_fill<8>(proj, mproj, b, s0, g, lane, tile); else pool_fill<16>(proj, mproj, b, s0, g, lane, tile);
    LDS_WAIT(); asm volatile("" ::: "memory");
    s16x8 Pf[2][8];
#pragma unroll
    for (int T = 0; T < 2; ++T) { const int tok = 32 * T + l31;
#pragma unroll
        for (int ks = 0; ks < 8; ++ks) Pf[T][ks] = *(const LAS s16x8*)(tile + tok * 256 + ((32 * ks + 16 * h2) ^ ((tok & 15) << 4))); }
    LDS_WAIT(); asm volatile("" ::: "memory");
    const bf16* wt = (const bf16*)(ws + WS_POOLW) + g * 16384; const float* psc = a.in[8] + g * 128;
#pragma unroll 1
    for (int Nb = 0; Nb < 4; ++Nb) {
        f32x16 acc0, acc1;
#pragma unroll
        for (int r = 0; r < 16; ++r) { acc0[r] = 0.f; acc1[r] = 0.f; }
        const bf16* wrow = wt + (size_t)(32 * Nb + l31) * 128 + 8 * h2;
#pragma unroll
        for (int ks = 0; ks < 8; ++ks) { const s16x8 Wf = *(const s16x8*)(wrow + 16 * ks); acc0 = mfma32(Wf, Pf[0][ks], acc0); acc1 = mfma32(Wf, Pf[1][ks], acc1); }
#pragma unroll
        for (int i = 0; i < 4; ++i) { const int d = 32 * Nb + 8 * i + 4 * h2; const f32x4 sc = *(const f32x4*)(psc + d);
            u32x2 w0, w1; w0.x = pk2(acc0[4 * i] * sc.x, acc0[4 * i + 1] * sc.y); w0.y = pk2(acc0[4 * i + 2] * sc.z, acc0[4 * i + 3] * sc.w);
            w1.x = pk2(acc1[4 * i] * sc.x, acc1[4 * i + 1] * sc.y); w1.y = pk2(acc1[4 * i + 2] * sc.z, acc1[4 * i + 3] * sc.w);
            const int t0 = l31, t1 = 32 + l31;
            *(LAS u32x2*)(tile + t0 * 256 + ((2 * d) ^ ((t0 & 15) << 4))) = w0; *(LAS u32x2*)(tile + t1 * 256 + ((2 * d) ^ ((t1 & 15) << 4))) = w1; }
    }
    LDS_WAIT(); asm volatile("" ::: "memory");
    bf16* ymix = (bf16*)(ws + WS_YMIX);
#pragma unroll
    for (int it = 0; it < 16; ++it) { const int row = 4 * it + (lane >> 4), ch = lane & 15;
        const v4u v = *(const LAS v4u*)(tile + row * 256 + ((ch ^ (row & 15)) << 4));
        *(v4u*)(ymix + (size_t)(m0 + row) * D + g * 128 + ch * 8) = v; }
    LDS_WAIT(); asm volatile("" ::: "memory");
}
constexpr int RING_OFF = 0, RING_BYTES = 131072;
constexpr int LDSCTL_OFF = RING_BYTES, MISC_OFF = LDSCTL_OFF + 320;
constexpr int LDS_BYTES = 147456;
constexpr int NWAVES = 8;
constexpr int CW_BAR = 4096;

__device__ __forceinline__ void transpose_item(const float* W, int ldw, const float* kscale, bf16* WT, int ldt, int k0, int n0, int drow0, LAS float* scr, int lane) {
#pragma unroll 8
    for (int i = 0; i < 32; ++i) { const int kk = 2 * i + (lane >> 5); float v = W[(size_t)(k0 + kk) * ldw + n0 + (lane & 31)]; if (kscale) v *= kscale[k0 + kk]; scr[kk * 33 + (lane & 31)] = v; }
    LDS_WAIT(); asm volatile("" ::: "memory");
    const int c = lane & 7;
#pragma unroll
    for (int j = 0; j < 4; ++j) { const int n = (lane >> 3) + 8 * j; const LAS float* s = scr + (8 * c) * 33 + n;
        v4u o; o.x = pk2(s[0 * 33], s[1 * 33]); o.y = pk2(s[2 * 33], s[3 * 33]); o.z = pk2(s[4 * 33], s[5 * 33]); o.w = pk2(s[6 * 33], s[7 * 33]);
        *(GAS v4u*)(WT + (size_t)(drow0 + n) * ldt + k0 + 8 * c) = o; }
    LDS_WAIT(); asm volatile("" ::: "memory");
}

__device__ __forceinline__ void p0_prologue(const Args& a, LAS unsigned char* lds, int vcu, int G) {
    const int tid = threadIdx.x, lane = tid & 63, wave = __builtin_amdgcn_readfirstlane(tid >> 6);
    const float* x = a.in[0]; const float* meta = a.in[1]; const float* nmw = a.in[2]; const float* w_in = a.in[3];
    unsigned char* ws = a.ws;
#ifndef SKIP_C
    if (vcu < 33) {
        LAS float* mu_t = (LAS float*)lds;
        LAS float* red = (LAS float*)(lds + 65536);
        LAS float* mrs = (LAS float*)(lds + 65536 + 32768);
        for (int i = tid; i < 16 * 1024; i += 512) { const int r = i >> 10, k = i & 1023; mu_t[k * 16 + r] = meta[i] * nmw[k]; }
#pragma unroll
        for (int rr = 0; rr < 2; ++rr) { const int r = 2 * wave + rr; float s = 0.f;
            for (int j = 0; j < 16; ++j) { const float v = meta[r * 1024 + lane + 64 * j]; s += v * v; }
            s = wave_sum(s); if (lane == 0) mrs[r] = rsqrtf(s * (1.f / D) + EPS); }
        __syncthreads();
        const int n = vcu * 64 + lane, nn = n < INC ? n : INC - 1;
        float acc[16];
#pragma unroll
        for (int r = 0; r < 16; ++r) acc[r] = 0.f;
        const float* wp = w_in + (size_t)(128 * wave) * INC + nn;
#pragma unroll 4
        for (int k = 0; k < 128; ++k) { const float wv = wp[(size_t)k * INC]; const LAS f32x4* m4 = (const LAS f32x4*)(mu_t + (128 * wave + k) * 16);
#pragma unroll
            for (int q = 0; q < 4; ++q) { const f32x4 mm = m4[q]; acc[4 * q] += mm.x * wv; acc[4 * q + 1] += mm.y * wv; acc[4 * q + 2] += mm.z * wv; acc[4 * q + 3] += mm.w * wv; } }
#pragma unroll
        for (int r = 0; r < 16; ++r) red[(wave * 16 + r) * 64 + lane] = acc[r];
        __syncthreads();
#pragma unroll
        for (int rr = 0; rr < 2; ++rr) { const int r = 2 * wave + rr; float s = 0.f;
#pragma unroll
            for (int w = 0; w < 8; ++w) s += red[(w * 16 + r) * 64 + lane];
            if (n < INC) ((float*)(ws + WS_MPROJ))[r * INC + n] = s * mrs[r]; }
        __syncthreads();
    }
#endif
#ifndef SKIP_A
    {
        LAS float* scr = (LAS float*)(lds + wave * 16384);
        const int gw = vcu * NWAVES + wave, NGW = G * NWAVES;
        constexpr int I_IN = 16 * 64, I_OUT = 16 * 32, I_PW = 4 * 8, I_GU = NEXP * 256, I_D = NEXP * 128;
        for (int it0 = gw; it0 < I_IN + I_OUT + I_PW + I_GU + I_D; it0 += NGW) {
            int it = it0;
            if (it < I_IN) { transpose_item(w_in, INC, nmw, (bf16*)(ws + WS_WIN), D, 64 * (it / 64), 32 * (it % 64), 32 * (it % 64), scr, lane); continue; } it -= I_IN;
            if (it < I_OUT) { transpose_item(a.in[9], D, nullptr, (bf16*)(ws + WS_WOUT), D, 64 * (it / 32), 32 * (it % 32), 32 * (it % 32), scr, lane); continue; } it -= I_OUT;
            if (it < I_PW) { const int g = it / 8, r = it % 8; transpose_item(a.in[7] + g * 16384, 128, nullptr, (bf16*)(ws + WS_POOLW) + g * 16384, 128, 64 * (r / 4), 32 * (r % 4), 32 * (r % 4), scr, lane); continue; } it -= I_PW;
            if (it < I_GU) { const int e = it / 256, r = it % 256, isup = r / 128, r2 = r % 128, kb = r2 / 8, nb = r2 % 8;
                const float* src = (isup ? a.in[16] : a.in[15]) + (size_t)e * D * EH;
                transpose_item(src, EH, a.in[10], (bf16*)(ws + WS_WGU) + (size_t)e * 512 * D, D, 64 * kb, 32 * nb, 256 * (nb >> 2) + 128 * isup + ((32 * nb) & 127), scr, lane); continue; } it -= I_GU;
            { const int e = it / 128, r = it % 128; transpose_item(a.in[17] + (size_t)e * EH * D, D, nullptr, (bf16*)(ws + WS_WD) + (size_t)e * D * EH, EH, 64 * (r / 32), 32 * (r % 32), 32 * (r % 32), scr, lane); }
        }
    }
#endif
    __syncthreads();
#ifndef SKIP_B
    {
        LAS float* wg = (LAS float*)lds;
        for (int i = tid; i < 16 * 1024; i += 512) { const int k = i >> 4, q = i & 15; wg[q * 1024 + k] = nmw[k] * w_in[(size_t)k * INC + C_G + q]; }
        __syncthreads();
        const int gw = vcu * NWAVES + wave, NGW = G * NWAVES;
        float* rstd1 = (float*)(ws + WS_RSTD1); float* glr = (float*)(ws + WS_GLR); bf16* A0 = (bf16*)(ws + WS_A0);
        for (int p = gw; p < TR / 2; p += NGW) {
            const GAS f32x4* x0 = (const GAS f32x4*)(x + (size_t)(2 * p) * D) + lane; const GAS f32x4* x1 = x0 + D / 4;
            f32x4 v0[4], v1[4]; float s0 = 0.f, s1 = 0.f;
#pragma unroll
            for (int j = 0; j < 4; ++j) { v0[j] = x0[64 * j]; v1[j] = x1[64 * j]; }
#pragma unroll
            for (int j = 0; j < 4; ++j) { s0 += (v0[j].x * v0[j].x + v0[j].y * v0[j].y) + (v0[j].z * v0[j].z + v0[j].w * v0[j].w); s1 += (v1[j].x * v1[j].x + v1[j].y * v1[j].y) + (v1[j].z * v1[j].z + v1[j].w * v1[j].w); }
            s0 = wave_sum(s0); s1 = wave_sum(s1);
            const float r0 = rsqrtf(s0 * (1.f / D) + EPS), r1 = rsqrtf(s1 * (1.f / D) + EPS);
            GAS unsigned long long* o0 = (GAS unsigned long long*)(A0 + (size_t)(2 * p) * D) + lane; GAS unsigned long long* o1 = o0 + D / 4;
#pragma unroll
            for (int j = 0; j < 4; ++j) { o0[64 * j] = (unsigned long long)pk2(v0[j].x, v0[j].y) | ((unsigned long long)pk2(v0[j].z, v0[j].w) << 32);
                                          o1[64 * j] = (unsigned long long)pk2(v1[j].x, v1[j].y) | ((unsigned long long)pk2(v1[j].z, v1[j].w) << 32); }
            if (lane == 0) { rstd1[2 * p] = r0; rstd1[2 * p + 1] = r1; }
            float ac[32];
#pragma unroll
            for (int q = 0; q < 16; ++q) { float t0 = 0.f, t1 = 0.f;
#pragma unroll
                for (int j = 0; j < 4; ++j) { const f32x4 w4 = *(const LAS f32x4*)(wg + q * 1024 + 4 * lane + 256 * j);
                    t0 += (v0[j].x * w4.x + v0[j].y * w4.y) + (v0[j].z * w4.z + v0[j].w * w4.w); t1 += (v1[j].x * w4.x + v1[j].y * w4.y) + (v1[j].z * w4.z + v1[j].w * w4.w); }
                ac[q] = t0; ac[16 + q] = t1; if (q & 1) asm volatile("" ::: "memory"); }
            float b16[16], b8[8], b4[4], b2[2];
            { const bool hi = lane & 32;
#pragma unroll
              for (int i = 0; i < 16; ++i) { const float keep = hi ? ac[16 + i] : ac[i], send = hi ? ac[i] : ac[16 + i]; b16[i] = keep + __shfl_xor(send, 32); } }
            { const bool hi = lane & 16;
#pragma unroll
              for (int i = 0; i < 8; ++i) { const float keep = hi ? b16[8 + i] : b16[i], send = hi ? b16[i] : b16[8 + i]; b8[i] = keep + __shfl_xor(send, 16); } }
            { const bool hi = lane & 8;
#pragma unroll
              for (int i = 0; i < 4; ++i) { const float keep = hi ? b8[4 + i] : b8[i], send = hi ? b8[i] : b8[4 + i]; b4[i] = keep + __shfl_xor(send, 8); } }
            { const bool hi = lane & 4;
#pragma unroll
              for (int i = 0; i < 2; ++i) { const float keep = hi ? b4[2 + i] : b4[i], send = hi ? b4[i] : b4[2 + i]; b2[i] = keep + __shfl_xor(send, 4); } }
            float b1; { const bool hi = lane & 2; const float keep = hi ? b2[1] : b2[0], send = hi ? b2[0] : b2[1]; b1 = keep + __shfl_xor(send, 2); }
            b1 += __shfl_xor(b1, 1);
            if (!(lane & 1)) { const int rw = lane >> 5, q = (lane >> 1) & 15; glr[(size_t)(2 * p + rw) * 16 + q] = b1 * (rw ? r1 : r0); }
        }
    }
#endif
}

__global__ void __launch_bounds__(NWAVES * 64, 2) mega(Args args) {
    extern __shared__ __attribute__((aligned(16))) unsigned char lds_raw[];
    LAS unsigned char* lds = (LAS unsigned char*)lds_raw;
    const int tid = threadIdx.x;
    const int G = gridDim.x; int vcu; { const int bx = blockIdx.x; vcu = (G % 8 == 0) ? (bx % 8) * (G / 8) + bx / 8 : bx; }
    for (int u = tid; u < (LDS_BYTES - LDSCTL_OFF) / 4; u += NWAVES * 64) ((LAS unsigned*)(lds + LDSCTL_OFF))[u] = 0u;
    __syncthreads();
    XcdBarrier bar = xcd_barrier_post((unsigned*)(args.ws + WS_CTL) + CW_BAR, (volatile LAS unsigned*)(lds + MISC_OFF) + 8);
    const int lo = args.ph_lo, hi = args.ph_hi;
#define IN(k) (lo <= (k) && (k) < hi)
#define BOTH(k) (IN(k) && IN((k) + 1))
    unsigned char* ws = args.ws;
    if (IN(0)) { p0_prologue(args, lds, vcu, G); if (BOTH(0)) xcd_barrier(bar); }
    if (IN(1)) {
        pg8::Gemm g{(const bf16*)(ws + WS_A0), (const bf16*)(ws + WS_WIN), TR, PC, D}; pg8::StaticOrder S; S.init(TR, PC, G, (int)blockIdx.x);
        pg8::EpiRowScaleBf16 E{(bf16*)(ws + WS_PROJ), PC, (const float*)(ws + WS_RSTD1)};
        pg8::gemm_phase<pg8::EpiRowScaleBf16, pg8::StaticOrder, PG8_ALIGN, PG8_SP2>(lds + RING_OFF, g, S, E);
        if (BOTH(1)) xcd_barrier(bar);
    }
    const int wave_ = __builtin_amdgcn_readfirstlane(tid >> 6), lane_ = tid & 63, gw_ = vcu * NWAVES + wave_, NGW_ = G * NWAVES;
    if (IN(2)) {
        if (gw_ < 32) gla_meta_unit(args, gw_, lane_);
        for (int u = gw_; u < 2048; u += NGW_) gla_pass1_unit(args, u, lane_);
        for (int u = gw_; u < 2048; u += NGW_) pool_unit(args, u, lane_, lds + wave_ * 16384);
        if (BOTH(2)) xcd_barrier(bar);
    }
    if (IN(3)) { gla_scan(args, (wave_ * G + vcu) * 64 + lane_, G * NWAVES * 64); if (BOTH(3)) xcd_barrier(bar); }
    if (IN(4)) { for (int u = gw_; u < 2048; u += NGW_) gla_pass2_unit(args, u, lane_); if (BOTH(4)) xcd_barrier(bar); }
#undef IN
#undef BOTH
}
__device__ __forceinline__ float pval(const bf16* proj, const float* mproj, int r, int c) { return r < NMETA ? mproj[r * INC + c] : bf2f(proj[(size_t)(r - NMETA) * PC + c]); }
__device__ __forceinline__ float gval(const float* glr, const float* mproj, int r, int q) { return r < NMETA ? mproj[r * INC + C_G + q] : glr[(size_t)(r - NMETA) * 16 + q]; }

__global__ void k_pooled(const bf16* proj, const float* mproj, float* pooled) {
    size_t idx = (size_t)blockIdx.x * 256 + threadIdx.x; if (idx >= (size_t)TR * 512) return;
    int m = (int)(idx >> 9), c = (int)(idx & 511); int g = c >> 7; int w = 2 << g;
    int b = m / SEQ, s = m % SEQ;
    float sum = 0.f;
    for (int j = 0; j < w; ++j) { int sp = s - j; int r = sp >= 0 ? NMETA + b * SEQ + sp : NMETA + sp; sum += pval(proj, mproj, r, C_POOL + c); }
    pooled[idx] = sum / (float)w - pval(proj, mproj, NMETA + m, C_POOL + c);
}
__global__ void k_poolmix(const float* pooled, const float* pool_w, const float* pool_scale, float* ymix) {
    size_t idx = (size_t)blockIdx.x * 256 + threadIdx.x; if (idx >= (size_t)TR * 512) return;
    int m = (int)(idx >> 9), c = (int)(idx & 511); int g = c >> 7, d = c & 127;
    const float* pr = pooled + (size_t)m * 512 + g * 128; const float* wp = pool_w + (size_t)g * 128 * 128 + d;
    float s = 0.f; for (int k = 0; k < 128; ++k) s += pr[k] * wp[(size_t)k * 128];
    ymix[(size_t)m * D + c] = s * pool_scale[c];
}
__global__ void k_decay(const float* glr, const float* mproj, const float* wgu, const float* bg, float* dec) {
    size_t idx = (size_t)blockIdx.x * 256 + threadIdx.x; if (idx >= (size_t)R * 256) return;
    int r = (int)(idx >> 8), j = (int)(idx & 255);
    float z = bg[j]; for (int q = 0; q < 16; ++q) z += gval(glr, mproj, r, q) * wgu[q * 256 + j];
    float ls = fminf(z, 0.f) - log1pf(expf(-fabsf(z)));
    dec[idx] = expf(ls / 16.f);
}
__global__ void k_gla(const bf16* proj, const float* mproj, const float* dec, float* ymix) {
    const int b = blockIdx.x >> 2, h = blockIdx.x & 3, v = threadIdx.x;
    float S[64];
#pragma unroll
    for (int d = 0; d < 64; ++d) S[d] = 0.f;
    for (int p = 0; p < NMETA; ++p) {
        const float* a = dec + (size_t)p * 256 + h * 64; const float* pr = mproj + p * INC;
        float vv = pr[C_V + h * 128 + v];
#pragma unroll
        for (int d = 0; d < 64; ++d) S[d] = a[d] * S[d] + pr[C_K + h * 64 + d] * vv;
    }
    for (int s = 0; s < SEQ; ++s) {
        const int m = b * SEQ + s;
        const float* a = dec + (size_t)(NMETA + m) * 256 + h * 64; const bf16* pr = proj + (size_t)m * PC;
        float vv = bf2f(pr[C_V + h * 128 + v]); float o = 0.f;
#pragma unroll
        for (int d = 0; d < 64; ++d) { S[d] = a[d] * S[d] + bf2f(pr[C_K + h * 64 + d]) * vv; o += bf2f(pr[C_Q + h * 64 + d]) * S[d]; }
        ymix[(size_t)m * D + 512 + h * 128 + v] = o * 0.125f;
    }
}
__global__ void k_glapost(const bf16* proj, const float* gnw, float* ymix) {
    int m = blockIdx.x >> 2, h = blockIdx.x & 3, v = threadIdx.x;
    float o = ymix[(size_t)m * D + 512 + h * 128 + v];
    __shared__ float red[128]; red[v] = o * o; __syncthreads();
    for (int s = 64; s > 0; s >>= 1) { if (v < s) red[v] += red[v + s]; __syncthreads(); }
    float rs = rsqrtf(red[0] / 128.f + EPS);
    float rr = bf2f(proj[(size_t)m * PC + C_R + h * 128 + v]);
    ymix[(size_t)m * D + 512 + h * 128 + v] = o * rs * gnw[v] * (rr / (1.f + expf(-rr)));
}
__global__ void k_gemm2(const bf16* A, const float* xres, const float* B, float* C, int M, int N, int K) {
    __shared__ float As[16][65], Bs[16][65];
    const int tx = threadIdx.x & 15, ty = threadIdx.x >> 4;
    const int m0 = blockIdx.y * 64, n0 = blockIdx.x * 64;
    float acc[4][4] = {};
    for (int k0 = 0; k0 < K; k0 += 16) {
        for (int i = threadIdx.x; i < 64 * 16; i += 256) { int mm = i >> 4, kk = i & 15; As[kk][mm] = bf2f(A[(size_t)(m0 + mm) * K + k0 + kk]); }
        for (int i = threadIdx.x; i < 64 * 16; i += 256) { int kk = i >> 6, nn = i & 63; Bs[kk][nn] = B[(size_t)(k0 + kk) * N + n0 + nn]; }
        __syncthreads();
#pragma unroll
        for (int kk = 0; kk < 16; ++kk) {
            float a[4], b[4];
#pragma unroll
            for (int i = 0; i < 4; ++i) { a[i] = As[kk][ty * 4 + i]; b[i] = Bs[kk][tx * 4 + i]; }
#pragma unroll
            for (int i = 0; i < 4; ++i)
#pragma unroll
                for (int j = 0; j < 4; ++j) acc[i][j] += a[i] * b[j];
        }
        __syncthreads();
    }
    for (int i = 0; i < 4; ++i) { int m = m0 + ty * 4 + i;
        for (int j = 0; j < 4; ++j) { int n = n0 + tx * 4 + j; C[(size_t)m * N + n] = acc[i][j] + xres[(size_t)m * N + n]; } }
}
__global__ void k_moe(float* out, const float* nfw, const float* wrg, const float* brg, const float* wre, const float* bre,
                      const float* wg, const float* wu, const float* wd, const float* fnw) {
    const int m = blockIdx.x, t = threadIdx.x;
    __shared__ float xn[1024], red[256], lg[20], hh[256], wsel[2]; __shared__ int esel[2];
    float* row = out + (size_t)m * D;
    float hv[4]; float s = 0.f;
    for (int i = 0; i < 4; ++i) { hv[i] = row[t + 256 * i]; s += hv[i] * hv[i]; }
    red[t] = s; __syncthreads();
    for (int o = 128; o > 0; o >>= 1) { if (t < o) red[t] += red[t + o]; __syncthreads(); }
    float rs = rsqrtf(red[0] / D + EPS); __syncthreads();
    for (int i = 0; i < 4; ++i) xn[t + 256 * i] = hv[i] * rs * nfw[t + 256 * i];
    __syncthreads();
    if (t < 20) { float a = 0.f;
        if (t < 4) { for (int k = 0; k < D; ++k) a += xn[k] * wrg[k * 4 + t]; a += brg[t]; }
        else { int e = t - 4; for (int k = 0; k < D; ++k) a += xn[k] * wre[k * 16 + e]; a += bre[e]; }
        lg[t] = a; }
    __syncthreads();
    if (t == 0) {
        int g = 0; for (int i = 1; i < 4; ++i) if (lg[i] > lg[g]) g = i;
        float mx = lg[g], den = 0.f; for (int i = 0; i < 4; ++i) den += expf(lg[i] - mx);
        float pg = 1.f / den;
        const float* el = lg + 4 + 4 * g;
        int i1 = 0; for (int i = 1; i < 4; ++i) if (el[i] > el[i1]) i1 = i;
        int i2 = -1; for (int i = 0; i < 4; ++i) if (i != i1 && (i2 < 0 || el[i] > el[i2])) i2 = i;
        float p1 = 1.f / (1.f + expf(el[i2] - el[i1])), p2 = 1.f - p1;
        esel[0] = g * 4 + i1; esel[1] = g * 4 + i2; wsel[0] = pg * p1; wsel[1] = pg * p2;
    }
    __syncthreads();
    float y[4] = {0.f, 0.f, 0.f, 0.f};
    for (int q = 0; q < 2; ++q) {
        const int e = esel[q]; const float we = wsel[q];
        const float* G = wg + (size_t)e * D * 256; const float* U = wu + (size_t)e * D * 256; const float* Dn = wd + (size_t)e * 256 * D;
        float a = 0.f, b = 0.f;
        for (int k = 0; k < D; ++k) { float xv = xn[k]; a += xv * G[(size_t)k * 256 + t]; b += xv * U[(size_t)k * 256 + t]; }
        __syncthreads();
        hh[t] = (a / (1.f + expf(-a))) * b;
        __syncthreads();
        for (int i = 0; i < 4; ++i) { float acc = 0.f; int c = t + 256 * i; for (int j = 0; j < 256; ++j) acc += hh[j] * Dn[(size_t)j * D + c]; y[i] += we * acc; }
    }
    s = 0.f; for (int i = 0; i < 4; ++i) { hv[i] += y[i]; s += hv[i] * hv[i]; }
    __syncthreads(); red[t] = s; __syncthreads();
    for (int o = 128; o > 0; o >>= 1) { if (t < o) red[t] += red[t + o]; __syncthreads(); }
    rs = rsqrtf(red[0] / D + EPS);
    for (int i = 0; i < 4; ++i) row[t + 256 * i] = hv[i] * rs * fnw[t + 256 * i];
}
#ifndef MEGA_PHASES
#define MEGA_PHASES 5
#endif
extern "C" void kernel_launch(void* const* d_in, const int* in_sizes, int n_in, void* d_out, int out_size, void* d_ws, size_t ws_size, hipStream_t stream) {
    static int grid = 0;
    if (grid == 0) {
        if (n_in != 19 || in_sizes[0] != TR * D || out_size != TR * D || ws_size < WS_END) { fprintf(stderr, "kernel_launch: unexpected shapes (n_in %d in0 %d out %d ws %zu); nothing launched\n", n_in, n_in > 0 ? in_sizes[0] : -1, out_size, ws_size); grid = -1; return; }
        int dev = 0, cus = 0, per_cu = 0;
        if (hipGetDevice(&dev) != hipSuccess || hipDeviceGetAttribute(&cus, hipDeviceAttributeMultiprocessorCount, dev) != hipSuccess) { grid = -1; return; }
        if (hipFuncSetAttribute((const void*)mega, hipFuncAttributeMaxDynamicSharedMemorySize, LDS_BYTES) != hipSuccess) { fprintf(stderr, "kernel_launch: hipFuncSetAttribute failed\n"); grid = -1; return; }
        if (hipOccupancyMaxActiveBlocksPerMultiprocessor(&per_cu, (const void*)mega, NWAVES * 64, LDS_BYTES) != hipSuccess || per_cu < 1) { fprintf(stderr, "kernel_launch: occupancy query says %d blocks/CU\n", per_cu); grid = -1; return; }
        grid = cus;
        fprintf(stderr, "kernel_launch: cus %d per_cu %d grid %d\n", cus, per_cu, grid);
    }
    if (grid < 0) return;
    if (hipMemsetAsync((char*)d_ws + WS_CTL, 0, CTL_ZERO_BYTES, stream) != hipSuccess) return;
    Args a{};
    for (int i = 0; i < 19; ++i) a.in[i] = (const float*)d_in[i];
    a.out = (float*)d_out; a.ws = (unsigned char*)d_ws; a.ph_lo = 0; a.ph_hi = MEGA_PHASES;
    void* kargs[] = {&a};
    hipError_t le = hipLaunchCooperativeKernel((const void*)mega, dim3(grid), dim3(NWAVES * 64), kargs, LDS_BYTES, stream);
    if (le != hipSuccess) { fprintf(stderr, "kernel_launch: cooperative launch failed: %s (grid %d)\n", hipGetErrorName(le), grid); return; }

    const float* x = a.in[0]; unsigned char* ws = (unsigned char*)d_ws; float* out = (float*)d_out;
    const bf16* ymix = (const bf16*)(ws + WS_YMIX);
    k_gemm2<<<dim3(D / 64, TR / 64), 256, 0, stream>>>(ymix, x, a.in[9], out, TR, D, D);
    k_moe<<<TR, 256, 0, stream>>>(out, a.in[10], a.in[11], a.in[12], a.in[13], a.in[14], a.in[15], a.in[16], a.in[17], a.in[18]);
}
```

```cpp
#include <hip/hip_runtime.h>
#include <cstdio>
#include <cstdint>

constexpr int D = 1024, BATCH = 4, SEQ = 8192, NMETA = 16;
constexpr int TR = BATCH * SEQ;
constexpr int R = NMETA + TR;
constexpr int INC = 2064;
constexpr int PC = 2048;
constexpr int C_POOL = 0, C_Q = 512, C_K = 768, C_V = 1024, C_R = 1536, C_G = 2048;
constexpr float EPS = 1e-6f;
constexpr int NEXP = 16, EH = 256;

constexpr size_t MiB = 1u << 20;
constexpr size_t WS_CTL = 0, CTL_ZERO_BYTES = 1 * MiB;
constexpr size_t WS_WIN = 2 * MiB;
constexpr size_t WS_WOUT = 6 * MiB;
constexpr size_t WS_POOLW = 8 * MiB;
constexpr size_t WS_WGU = 9 * MiB;
constexpr size_t WS_WD = 25 * MiB;
constexpr size_t WS_RSTD1 = 33 * MiB;
constexpr size_t WS_MPROJ = 33 * MiB + 256 * 1024;
constexpr size_t WS_GLR = 34 * MiB;
constexpr size_t WS_ROUTE = 37 * MiB;
constexpr size_t WS_A0 = 48 * MiB;
constexpr size_t WS_PROJ = 112 * MiB;
constexpr size_t WS_YMIX = 240 * MiB;
constexpr size_t WS_DS = 304 * MiB;
constexpr size_t WS_SS = 340 * MiB;
constexpr size_t WS_XS = 376 * MiB;
constexpr size_t WS_H = 456 * MiB;
constexpr size_t WS_END = 496 * MiB;
constexpr size_t WSN_YMIX = 240 * MiB;
constexpr size_t WSN_POOLED = 376 * MiB;
constexpr size_t WSN_DEC = 456 * MiB;

#define GAS __attribute__((address_space(1)))
#define LAS __attribute__((address_space(3)))
typedef unsigned short bf16;
typedef unsigned v4u __attribute__((ext_vector_type(4)));
typedef float f32x4 __attribute__((ext_vector_type(4)));
typedef GAS unsigned gu32;
#define RLX_AGENT __ATOMIC_RELAXED, __HIP_MEMORY_SCOPE_AGENT
#define LDS_WAIT() asm volatile("s_waitcnt lgkmcnt(0)" ::: "memory")
#define VM_WAIT() asm volatile("s_waitcnt vmcnt(0)" ::: "memory")
__device__ __forceinline__ unsigned f2bf(float f) { unsigned u = __builtin_bit_cast(unsigned, f); return (u + 0x7fffu + ((u >> 16) & 1u)) >> 16; }
__device__ __forceinline__ unsigned pk2(float lo, float hi) { return f2bf(lo) | (f2bf(hi) << 16); }
__device__ __forceinline__ float bf2f(bf16 b) { return __uint_as_float((unsigned)b << 16); }
__device__ __forceinline__ float wave_sum(float v) {
#pragma unroll
    for (int o = 1; o < 64; o <<= 1) v += __shfl_xor(v, o);
    return v;
}

constexpr int RING_OFF = 0, RING_BYTES = 131072;
constexpr int LDSCTL_OFF = RING_BYTES, MISC_OFF = LDSCTL_OFF + 320;
constexpr int LDS_BYTES = 147456;
constexpr int NWAVES = 8;
constexpr int CW_BAR = 4096;

struct Args { const float* in[19]; float* out; unsigned char* ws; int ph_lo, ph_hi; };

namespace pg8 {
#define PG8_LAS __attribute__((address_space(3)))
typedef unsigned short bf16_t;
typedef short bf16x8 __attribute__((ext_vector_type(8)));
typedef float f32x4 __attribute__((ext_vector_type(4)));
typedef unsigned u32x4 __attribute__((ext_vector_type(4)));
constexpr int BM = 256, BK = 64, HALF = 128, HTB = HALF * BK * 2  , STAGE_BYTES = 8 * HTB, NXCD = 8, WGM = 8;

__host__ __device__ __forceinline__ int lds_byte(int r, int c) { const int st = (r >> 4) * 2 + (c >> 5), rr = r & 15, cc = c & 31, ob = rr * 64 + cc * 2; return st * 1024 + (ob ^ (((ob >> 9) & 1) << 5)); }
__host__ __device__ __forceinline__ void stage_rc(int b, int& R, int& C) { const int st = b / 1024, sb = b % 1024, swz = sb ^ (((sb >> 9) & 1) << 5); R = (st >> 1) * 16 + swz / 64; C = (st & 1) * 32 + (swz % 64) / 2; }
__host__ __device__ __forceinline__ int perm32(int rho) { const int n = rho >> 4, i = rho & 15; return 8 * (i >> 2) + 4 * n + (i & 3); }

struct Unit { int pm, pn, cls, nrows; };
struct Gemm { const bf16_t* A; const bf16_t* Bt; int M, N, K; };

struct StaticOrder {
    int nM, nN, nwg, G, c;
    __host__ __device__ void init(int M, int N, int G_, int c_) { nM = M / BM; nN = N / BM; nwg = nM * nN; G = G_; c = c_; }
    __host__ __device__ bool next(int i, Unit& u) const {
        const long L = (long)i * G + c; if (L >= nwg) return false;
        int wgid = (int)L; { const int q = nwg / NXCD, r = nwg % NXCD, xcd = wgid % NXCD, off = wgid / NXCD; wgid = (xcd < r ? xcd * (q + 1) : r * (q + 1) + (xcd - r) * q) + off; }
        const int nig = WGM * nN, gid = wgid / nig, fm = gid * WGM, gsz = (nM - fm) < WGM ? (nM - fm) : WGM;
        u.pm = fm + ((wgid % nig) % gsz); u.pn = (wgid % nig) / gsz; return true;
    }
    __device__ __forceinline__ void a_ready(const Unit&) const {}
    __device__ __forceinline__ void done(const Unit&) const {}
};
__device__ __forceinline__ unsigned cvt_pk_bf16(float lo, float hi) { unsigned r; asm volatile("v_cvt_pk_bf16_f32 %0, %1, %2" : "=v"(r) : "v"(lo), "v"(hi)); return r; }
typedef float f32x2 __attribute__((ext_vector_type(2)));
template <class Epi, class Sched, bool ALIGN_EPI = false, bool SP2 = false>
__device__ __forceinline__ void gemm_phase(PG8_LAS unsigned char* lds, const Gemm g, const Sched& S, const Epi& E) {
    const int tid = threadIdx.x, wid = __builtin_amdgcn_readfirstlane(tid >> 6), lane = tid & 63, wr = wid >> 2, wc = wid & 3, fr = lane & 15, fq = lane >> 4;
    const int K = g.K, nt = K / BK;
    unsigned voffA[2], voffB[2];
#pragma unroll
    for (int i = 0; i < 2; ++i) { int R, C; stage_rc(tid * 16 + i * 8192, R, C); const int Rb = Epi::PERM ? ((R & ~31) + perm32(R & 31)) : R;
        voffA[i] = (unsigned)(R * K + C) * 2u; voffB[i] = (unsigned)(Rb * K + C) * 2u; }
    const size_t kstep = (size_t)(BK * 2);
    const size_t hstep = (size_t)HALF * K * 2;
    const size_t tstep = 2 * hstep;
    const unsigned ldsw = (unsigned)wid * 1024u;
    const int aoff = lds_byte(wr * 64 + fr, fq * 8), boff = lds_byte(wc * 32 + fr, fq * 8);
#define PG8_SA(b, h) (((b) * 2 + (h)) * HTB)
#define PG8_SB(b, h) ((4 + (b) * 2 + (h)) * HTB)
#define PG8_STAGE(bufoff, gbase, voff) do { _Pragma("unroll") for (int _i = 0; _i < 2; ++_i) \
        __builtin_amdgcn_global_load_lds((const unsigned*)((const char*)(gbase) + (voff)[_i]), (PG8_LAS unsigned*)(lds + (bufoff) + ldsw + _i * 8192), 16, 0, 0); } while (0)
#define PG8_LDA(dst, b, h) do { _Pragma("unroll") for (int m = 0; m < 4; ++m) _Pragma("unroll") for (int k = 0; k < 2; ++k) dst[m][k] = *(const PG8_LAS bf16x8*)(lds + PG8_SA(b, h) + aoff + m * 2048 + k * 1024); } while (0)
#define PG8_LDB(dst, b, h) do { _Pragma("unroll") for (int n = 0; n < 2; ++n) _Pragma("unroll") for (int k = 0; k < 2; ++k) dst[n][k] = *(const PG8_LAS bf16x8*)(lds + PG8_SB(b, h) + boff + n * 2048 + k * 1024); } while (0)
#define PG8_MMA(ai, bj, At, Bt) do { __builtin_amdgcn_s_setprio(1); _Pragma("unroll") for (int m = 0; m < 4; ++m) _Pragma("unroll") for (int n = 0; n < 2; ++n) _Pragma("unroll") for (int k = 0; k < 2; ++k) \
        acc[ai][bj][m][n] = __builtin_amdgcn_mfma_f32_16x16x32_bf16(Bt[n][k], At[m][k], acc[ai][bj][m][n], 0, 0, 0); __builtin_amdgcn_s_setprio(0); } while (0)
#define PG8_WAIT_V(n) asm volatile("s_waitcnt vmcnt(" #n ")" ::: "memory")
#define PG8_WAIT_L(n) asm volatile("s_waitcnt lgkmcnt(" #n ")" ::: "memory")
#define PG8_BAR __builtin_amdgcn_s_barrier()
#define PG8_SCHED __builtin_amdgcn_sched_barrier(0)
    Unit cur, nxt; int ui = 0;
    if (!S.next(0, cur)) return;
    f32x4 acc[2][2][4][2];
#pragma unroll
    for (int a = 0; a < 2; ++a)
#pragma unroll
        for (int b = 0; b < 2; ++b)
#pragma unroll
            for (int m = 0; m < 4; ++m)
#pragma unroll
                for (int n = 0; n < 2; ++n) acc[a][b][m][n] = (f32x4){0.f, 0.f, 0.f, 0.f};
    bf16x8 At[4][2], B0[2][2], B1[2][2];
    const char* cA = (const char*)g.A + (size_t)cur.pm * tstep; const char* cB = (const char*)g.Bt + (size_t)cur.pn * tstep;
    S.a_ready(cur);
    if constexpr (SP2) {
        PG8_STAGE(PG8_SB(0, 0), cB, voffB); PG8_STAGE(PG8_SB(0, 1), cB + hstep, voffB); PG8_STAGE(PG8_SA(0, 0), cA, voffA); PG8_STAGE(PG8_SA(0, 1), cA + hstep, voffA);
        if (wr == 1) PG8_BAR;
        PG8_WAIT_V(2); PG8_BAR;
        PG8_STAGE(PG8_SB(1, 0), cB + kstep, voffB); PG8_STAGE(PG8_SA(1, 0), cA + kstep, voffA); PG8_STAGE(PG8_SB(1, 1), cB + hstep + kstep, voffB);
        PG8_WAIT_V(6); PG8_BAR;
    } else {
        PG8_STAGE(PG8_SB(0, 0), cB, voffB); PG8_STAGE(PG8_SA(0, 0), cA, voffA); PG8_STAGE(PG8_SB(0, 1), cB + hstep, voffB); PG8_STAGE(PG8_SA(0, 1), cA + hstep, voffA);
        if (wr == 1) PG8_BAR;
        PG8_WAIT_V(4); PG8_BAR;
        PG8_STAGE(PG8_SB(1, 0), cB + kstep, voffB); PG8_STAGE(PG8_SA(1, 0), cA + kstep, voffA); PG8_STAGE(PG8_SB(1, 1), cB + hstep + kstep, voffB);
        PG8_WAIT_V(6); PG8_BAR;
    }
    for (;;) {
        const bool has_next = S.next(ui + 1, nxt);
        const char* nA = has_next ? (const char*)g.A + (size_t)nxt.pm * tstep : cA; const char* nB = has_next ? (const char*)g.Bt + (size_t)nxt.pn * tstep : cB;
        for (int t = 0; t < nt; t += 2) {
            const bool last = (t == nt - 2);
            const char* a1 = cA + (size_t)(t + 1) * kstep;
            const char* a2 = last ? nA : cA + (size_t)(t + 2) * kstep; const char* b2 = last ? nB : cB + (size_t)(t + 2) * kstep;
            const char* a3 = a2 + kstep; const char* b3 = b2 + kstep;
            if (last && has_next) S.a_ready(nxt);
            if constexpr (SP2) {
            PG8_LDB(B0, 0, 0); PG8_LDB(B1, 0, 1); PG8_SCHED; PG8_LDA(At, 0, 0); PG8_STAGE(PG8_SA(1, 1), a1 + hstep, voffA);
            PG8_WAIT_V(8); PG8_WAIT_L(0); PG8_BAR; PG8_MMA(0, 0, At, B0); PG8_MMA(0, 1, At, B1); PG8_BAR; PG8_SCHED;
            PG8_LDA(At, 0, 1); PG8_STAGE(PG8_SB(0, 0), b2, voffB); PG8_STAGE(PG8_SB(0, 1), b2 + hstep, voffB); PG8_STAGE(PG8_SA(0, 0), a2, voffA);
            PG8_WAIT_V(8); PG8_WAIT_L(0); PG8_BAR; PG8_MMA(1, 0, At, B0); PG8_MMA(1, 1, At, B1); PG8_BAR; PG8_SCHED;
            PG8_LDB(B0, 1, 0); PG8_LDB(B1, 1, 1); PG8_SCHED; PG8_LDA(At, 1, 0); PG8_STAGE(PG8_SA(0, 1), a2 + hstep, voffA);
            PG8_WAIT_V(8); PG8_WAIT_L(0); PG8_BAR; PG8_MMA(0, 0, At, B0); PG8_MMA(0, 1, At, B1); PG8_BAR; PG8_SCHED;
            PG8_LDA(At, 1, 1); PG8_STAGE(PG8_SB(1, 0), b3, voffB); PG8_STAGE(PG8_SB(1, 1), b3 + hstep, voffB); PG8_STAGE(PG8_SA(1, 0), a3, voffA);
            PG8_WAIT_V(8); PG8_WAIT_L(0); PG8_BAR; PG8_MMA(1, 0, At, B0); PG8_MMA(1, 1, At, B1); PG8_BAR; PG8_SCHED;
            } else {
            PG8_LDB(B0, 0, 0); PG8_SCHED; PG8_LDA(At, 0, 0); PG8_STAGE(PG8_SA(1, 1), a1 + hstep, voffA);
            PG8_WAIT_L(8); PG8_BAR; PG8_WAIT_L(0); PG8_MMA(0, 0, At, B0); PG8_BAR; PG8_SCHED;
            PG8_LDB(B1, 0, 1); PG8_STAGE(PG8_SB(0, 0), b2, voffB);
            PG8_BAR; PG8_WAIT_L(0); PG8_MMA(0, 1, At, B1); PG8_BAR;
            PG8_LDA(At, 0, 1); PG8_STAGE(PG8_SA(0, 0), a2, voffA);
            PG8_BAR; PG8_WAIT_L(0); PG8_MMA(1, 0, At, B0); PG8_BAR; PG8_SCHED;
            PG8_STAGE(PG8_SB(0, 1), b2 + hstep, voffB);
            PG8_WAIT_V(6); PG8_BAR; PG8_MMA(1, 1, At, B1); PG8_BAR;
            PG8_LDB(B0, 1, 0); PG8_SCHED; PG8_LDA(At, 1, 0); PG8_STAGE(PG8_SA(0, 1), a2 + hstep, voffA);
            PG8_WAIT_L(8); PG8_BAR; PG8_WAIT_L(0); PG8_MMA(0, 0, At, B0); PG8_BAR; PG8_SCHED;
            PG8_LDB(B1, 1, 1); PG8_STAGE(PG8_SB(1, 0), b3, voffB);
            PG8_BAR; PG8_WAIT_L(0); PG8_MMA(0, 1, At, B1); PG8_BAR;
            PG8_LDA(At, 1, 1); PG8_STAGE(PG8_SA(1, 0), a3, voffA);
            PG8_BAR; PG8_WAIT_L(0); PG8_MMA(1, 0, At, B0); PG8_BAR; PG8_SCHED;
            PG8_STAGE(PG8_SB(1, 1), b3 + hstep, voffB);
            PG8_WAIT_V(6); PG8_BAR; PG8_MMA(1, 1, At, B1); PG8_BAR;
            }
        }
        if constexpr (ALIGN_EPI) { if (wr == 0) PG8_BAR; }
        if constexpr (!Epi::AFTER_DRAIN) { E(acc, cur, wr, wc, fr, fq); S.done(cur); }
        if (!has_next) break;
#pragma unroll
        for (int a = 0; a < 2; ++a)
#pragma unroll
            for (int b = 0; b < 2; ++b)
#pragma unroll
                for (int m = 0; m < 4; ++m)
#pragma unroll
                    for (int n = 0; n < 2; ++n) acc[a][b][m][n] = (f32x4){0.f, 0.f, 0.f, 0.f};
        cur = nxt; cA = nA; cB = nB; ++ui;
        if constexpr (ALIGN_EPI) { if (wr == 1) PG8_BAR; }
    }
    PG8_WAIT_V(0);
    if constexpr (!ALIGN_EPI) { if (wr == 0) PG8_BAR; }
    PG8_BAR;
    if constexpr (Epi::AFTER_DRAIN) { E.fused(acc, cur, wr, wc, fr, fq, lds, wid, lane); S.done(cur); }
#undef PG8_SA
#undef PG8_SB
#undef PG8_STAGE
#undef PG8_LDA
#undef PG8_LDB
#undef PG8_MMA
#undef PG8_WAIT_V
#undef PG8_WAIT_L
#undef PG8_BAR
#undef PG8_SCHED
}
template <class Epi, class Sched, bool ALIGN_EPI>
__device__ __forceinline__ void gemm_phase2(PG8_LAS unsigned char* lds, const char* Abase, const int K, const int ldb, const Sched& S, const Epi& E) {
    const int tid = threadIdx.x, wid = __builtin_amdgcn_readfirstlane(tid >> 6), lane = tid & 63, wr = wid >> 2, wc = wid & 3, fr = lane & 15, fq = lane >> 4;
    const int nt = K / BK;
    int RA[2], CA[2]; unsigned voffB[2];
#pragma unroll
    for (int i = 0; i < 2; ++i) { int R, C; stage_rc(tid * 16 + i * 8192, R, C); const int Rb = Epi::PERM ? ((R & ~31) + perm32(R & 31)) : R;
        RA[i] = R; CA[i] = C * 2; voffB[i] = (unsigned)(Rb * ldb + C) * 2u; }
    const size_t kstep = (size_t)(BK * 2);
    const size_t hstepB = (size_t)HALF * ldb * 2;
    const unsigned ldsw = (unsigned)wid * 1024u;
    const int aoff = lds_byte(wr * 64 + fr, fq * 8), boff = lds_byte(wc * 32 + fr, fq * 8);
    const int bsplit = S.bsplit;
#define PG8_SA(b, h) (((b) * 2 + (h)) * HTB)
#define PG8_SB(b, h) ((4 + (b) * 2 + (h)) * HTB)
#define PG8_STAGE(bufoff, gbase, voff) do { _Pragma("unroll") for (int _i = 0; _i < 2; ++_i) \
        __builtin_amdgcn_global_load_lds((const unsigned*)((const char*)(gbase) + (voff)[_i]), (PG8_LAS unsigned*)(lds + (bufoff) + ldsw + _i * 8192), 16, 0, 0); } while (0)
#define PG8_BT(base, delta, tt) ((base) + (size_t)(tt) * kstep + ((tt) >= bsplit ? (delta) : (long)0))
#define PG8_LDA(dst, b, h) do { _Pragma("unroll") for (int m = 0; m < 4; ++m) _Pragma("unroll") for (int k = 0; k < 2; ++k) dst[m][k] = *(const PG8_LAS bf16x8*)(lds + PG8_SA(b, h) + aoff + m * 2048 + k * 1024); } while (0)
#define PG8_LDB(dst, b, h) do { _Pragma("unroll") for (int n = 0; n < 2; ++n) _Pragma("unroll") for (int k = 0; k < 2; ++k) dst[n][k] = *(const PG8_LAS bf16x8*)(lds + PG8_SB(b, h) + boff + n * 2048 + k * 1024); } while (0)
#define PG8_MMA(ai, bj, At, Bt) do { __builtin_amdgcn_s_setprio(1); _Pragma("unroll") for (int m = 0; m < 4; ++m) _Pragma("unroll") for (int n = 0; n < 2; ++n) _Pragma("unroll") for (int k = 0; k < 2; ++k) \
        acc[ai][bj][m][n] = __builtin_amdgcn_mfma_f32_16x16x32_bf16(Bt[n][k], At[m][k], acc[ai][bj][m][n], 0, 0, 0); __builtin_amdgcn_s_setprio(0); } while (0)
#define PG8_WAIT_V(n) asm volatile("s_waitcnt vmcnt(" #n ")" ::: "memory")
#define PG8_WAIT_L(n) asm volatile("s_waitcnt lgkmcnt(" #n ")" ::: "memory")
#define PG8_BAR __builtin_amdgcn_s_barrier()
#define PG8_SCHED __builtin_amdgcn_sched_barrier(0)
    Unit cur, nxt; int ui = 0;
    if (!S.next(0, cur)) return;
    f32x4 acc[2][2][4][2];
#pragma unroll
    for (int a = 0; a < 2; ++a)
#pragma unroll
        for (int b = 0; b < 2; ++b)
#pragma unroll
            for (int m = 0; m < 4; ++m)
#pragma unroll
                for (int n = 0; n < 2; ++n) acc[a][b][m][n] = (f32x4){0.f, 0.f, 0.f, 0.f};
    bf16x8 At[4][2], B0[2][2], B1[2][2];
    unsigned oc[2][2], on[2][2];
    S.a_offs(cur, RA, CA, oc);
    const char* cB = S.b_base(cur); long cD = S.b_delta(cur);
    PG8_STAGE(PG8_SB(0, 0), PG8_BT(cB, cD, 0), voffB); PG8_STAGE(PG8_SB(0, 1), PG8_BT(cB, cD, 0) + hstepB, voffB); PG8_STAGE(PG8_SA(0, 0), Abase, oc[0]); PG8_STAGE(PG8_SA(0, 1), Abase, oc[1]);
    if (wr == 1) PG8_BAR;
    PG8_WAIT_V(2); PG8_BAR;
    PG8_STAGE(PG8_SB(1, 0), PG8_BT(cB, cD, 1), voffB); PG8_STAGE(PG8_SA(1, 0), Abase + kstep, oc[0]); PG8_STAGE(PG8_SB(1, 1), PG8_BT(cB, cD, 1) + hstepB, voffB);
    PG8_WAIT_V(6); PG8_BAR;
    for (;;) {
        const bool has_next = S.next(ui + 1, nxt);
        if (!has_next) nxt = cur;
        S.a_offs(nxt, RA, CA, on);
        const char* nB = S.b_base(nxt); const long nD = S.b_delta(nxt);
        for (int t = 0; t < nt; t += 2) {
            const bool last = (t == nt - 2);
            const char* a1 = Abase + (size_t)(t + 1) * kstep;
            const char* a2 = last ? Abase : Abase + (size_t)(t + 2) * kstep; const char* a3 = a2 + kstep;
            const char* b2 = last ? PG8_BT(nB, nD, 0) : PG8_BT(cB, cD, t + 2); const char* b3 = last ? PG8_BT(nB, nD, 1) : PG8_BT(cB, cD, t + 3);
            unsigned o2[2][2];
#pragma unroll
            for (int h = 0; h < 2; ++h)
#pragma unroll
                for (int i = 0; i < 2; ++i) o2[h][i] = last ? on[h][i] : oc[h][i];
            PG8_LDB(B0, 0, 0); PG8_LDB(B1, 0, 1); PG8_SCHED; PG8_LDA(At, 0, 0); PG8_STAGE(PG8_SA(1, 1), a1, oc[1]);
            PG8_WAIT_V(8); PG8_WAIT_L(0); PG8_BAR; PG8_MMA(0, 0, At, B0); PG8_MMA(0, 1, At, B1); PG8_BAR; PG8_SCHED;
            PG8_LDA(At, 0, 1); PG8_STAGE(PG8_SB(0, 0), b2, voffB); PG8_STAGE(PG8_SB(0, 1), b2 + hstepB, voffB); PG8_STAGE(PG8_SA(0, 0), a2, o2[0]);
            PG8_WAIT_V(8); PG8_WAIT_L(0); PG8_BAR; PG8_MMA(1, 0, At, B0); PG8_MMA(1, 1, At, B1); PG8_BAR; PG8_SCHED;
            PG8_LDB(B0, 1, 0); PG8_LDB(B1, 1, 1); PG8_SCHED; PG8_LDA(At, 1, 0); PG8_STAGE(PG8_SA(0, 1), a2, o2[1]);
            PG8_WAIT_V(8); PG8_WAIT_L(0); PG8_BAR; PG8_MMA(0, 0, At, B0); PG8_MMA(0, 1, At, B1); PG8_BAR; PG8_SCHED;
            PG8_LDA(At, 1, 1); PG8_STAGE(PG8_SB(1, 0), b3, voffB); PG8_STAGE(PG8_SB(1, 1), b3 + hstepB, voffB); PG8_STAGE(PG8_SA(1, 0), a3, o2[0]);
            PG8_WAIT_V(8); PG8_WAIT_L(0); PG8_BAR; PG8_MMA(1, 0, At, B0); PG8_MMA(1, 1, At, B1); PG8_BAR; PG8_SCHED;
        }
        if constexpr (ALIGN_EPI) { if (wr == 0) PG8_BAR; }
        E(acc, cur, wr, wc, fr, fq);
        if (!has_next) break;
#pragma unroll
        for (int a = 0; a < 2; ++a)
#pragma unroll
            for (int b = 0; b < 2; ++b)
#pragma unroll
                for (int m = 0; m < 4; ++m)
#pragma unroll
                    for (int n = 0; n < 2; ++n) acc[a][b][m][n] = (f32x4){0.f, 0.f, 0.f, 0.f};
        cur = nxt; cB = nB; cD = nD; ++ui;
#pragma unroll
        for (int h = 0; h < 2; ++h)
#pragma unroll
            for (int i = 0; i < 2; ++i) oc[h][i] = on[h][i];
        if constexpr (ALIGN_EPI) { if (wr == 1) PG8_BAR; }
    }
    PG8_WAIT_V(0);
    if constexpr (!ALIGN_EPI) { if (wr == 0) PG8_BAR; }
    PG8_BAR;
#undef PG8_SA
#undef PG8_SB
#undef PG8_STAGE
#undef PG8_BT
#undef PG8_LDA
#undef PG8_LDB
#undef PG8_MMA
#undef PG8_WAIT_V
#undef PG8_WAIT_L
#undef PG8_BAR
#undef PG8_SCHED
}
struct DenseOrder : StaticOrder {
    int lda, ldb; const char* Bt; int bsplit;
    __device__ __forceinline__ void a_offs(const Unit& u, const int (&RA)[2], const int (&CA)[2], unsigned (&o)[2][2]) const {
#pragma unroll
        for (int h = 0; h < 2; ++h)
#pragma unroll
            for (int i = 0; i < 2; ++i) o[h][i] = (unsigned)((u.pm * BM + h * HALF + RA[i]) * lda) * 2u + (unsigned)CA[i]; }
    __device__ __forceinline__ const char* b_base(const Unit& u) const { return Bt + (size_t)u.pn * BM * ldb * 2; }
    __device__ __forceinline__ long b_delta(const Unit&) const { return 0; }
};
struct EpiResF32 {
    static constexpr bool PERM = false, AFTER_DRAIN = false;
    float* C; const float* res; int ldc;
    __device__ __forceinline__ void operator()(const f32x4 (&acc)[2][2][4][2], const Unit& u, int wr, int wc, int fr, int fq) const {
        const int row0 = u.pm * BM + wr * 64 + fr, col0 = u.pn * BM + wc * 32 + 4 * fq;
#pragma unroll
        for (int ai = 0; ai < 2; ++ai)
#pragma unroll
            for (int m = 0; m < 4; ++m) { const size_t off = (size_t)(row0 + ai * HALF + m * 16) * ldc + col0;
#pragma unroll
                for (int bj = 0; bj < 2; ++bj)
#pragma unroll
                    for (int n = 0; n < 2; ++n) { const f32x4 r = *(const f32x4*)(res + off + bj * HALF + n * 16); *(f32x4*)(C + off + bj * HALF + n * 16) = acc[ai][bj][m][n] + r; }
                if (m & 1) asm volatile("" ::: "memory"); }
    }
};
__device__ __forceinline__ void cls_experts(int cls, int& elo, int& ehi) { const int g = cls / 6, p = cls - 6 * g; const int lo = p < 3 ? 0 : (p < 5 ? 1 : 2), hi = p < 3 ? p + 1 : (p < 5 ? p - 1 : 3); elo = 4 * g + lo; ehi = 4 * g + hi; }
struct MoeTables { const PG8_LAS int* cls_off; const PG8_LAS int* cls_tot; const PG8_LAS int* tilecls; int ntiles; };
struct MoeUpOrder {
    MoeTables T; int G, c; const int* list; const char* Wgu; int bsplit;
    __device__ __forceinline__ bool next(int i, Unit& u) const { const int L = i * G + c; const int mt = L >> 2; if (mt >= T.ntiles) return false; u.pm = mt; u.pn = L & 3; u.cls = T.tilecls[mt]; u.nrows = 0; return true; }
    __device__ __forceinline__ void a_offs(const Unit& u, const int (&RA)[2], const int (&CA)[2], unsigned (&o)[2][2]) const {
#pragma unroll
        for (int h = 0; h < 2; ++h)
#pragma unroll
            for (int i = 0; i < 2; ++i) o[h][i] = (unsigned)list[u.pm * BM + h * HALF + RA[i]] * 2048u + (unsigned)CA[i]; }
    __device__ __forceinline__ const char* b_base(const Unit& u) const { int elo, ehi; cls_experts(u.cls, elo, ehi); const int e = (u.pn >> 1) ? ehi : elo; return Wgu + ((size_t)e * 512 + 256 * (u.pn & 1)) * 2048; }
    __device__ __forceinline__ long b_delta(const Unit&) const { return 0; }
};
struct MoeDownOrder {
    MoeTables T; int G, c; const char* Wd; int bsplit;
    __device__ __forceinline__ bool next(int i, Unit& u) const { const int L = i * G + c; const int mt = L >> 2; if (mt >= T.ntiles) return false; u.pm = mt; u.pn = L & 3; u.cls = T.tilecls[mt];
        const int rem = T.cls_off[u.cls] + T.cls_tot[u.cls] - mt * BM; u.nrows = rem < BM ? rem : BM; return true; }
    __device__ __forceinline__ void a_offs(const Unit& u, const int (&RA)[2], const int (&CA)[2], unsigned (&o)[2][2]) const {
#pragma unroll
        for (int h = 0; h < 2; ++h)
#pragma unroll
            for (int i = 0; i < 2; ++i) o[h][i] = (unsigned)(u.pm * BM + h * HALF + RA[i]) * 1024u + (unsigned)CA[i]; }
    __device__ __forceinline__ const char* b_base(const Unit& u) const { int elo, ehi; cls_experts(u.cls, elo, ehi); return Wd + ((size_t)elo * 1024 + 256 * u.pn) * 512; }
    __device__ __forceinline__ long b_delta(const Unit& u) const { int elo, ehi; cls_experts(u.cls, elo, ehi); return (long)(ehi - elo) * 1024 * 512 - 4 * 128; }
};
struct EpiSwiGLU {
    static constexpr bool PERM = true, AFTER_DRAIN = false;
    bf16_t* H; const float* wsorted;
    __device__ __forceinline__ void operator()(const f32x4 (&acc)[2][2][4][2], const Unit& u, int wr, int wc, int fr, int fq) const {
        const int row0 = u.pm * BM + wr * 64 + fr, q = u.pn >> 1, col0 = 256 * q + 128 * (u.pn & 1) + wc * 32 + 8 * fq;
#pragma unroll
        for (int ai = 0; ai < 2; ++ai)
#pragma unroll
            for (int m = 0; m < 4; ++m) { const int row = row0 + ai * HALF + m * 16; const float w = wsorted[2 * row + q];
                float o[8];
#pragma unroll
                for (int n = 0; n < 2; ++n)
#pragma unroll
                    for (int j = 0; j < 4; ++j) { const float g = acc[ai][0][m][n][j], up = acc[ai][1][m][n][j]; o[4 * n + j] = w * up * g * __builtin_amdgcn_rcpf(1.f + __expf(-g)); }
                u32x4 pk; pk.x = cvt_pk_bf16(o[0], o[1]); pk.y = cvt_pk_bf16(o[2], o[3]); pk.z = cvt_pk_bf16(o[4], o[5]); pk.w = cvt_pk_bf16(o[6], o[7]);
                *(u32x4*)(H + (size_t)row * 512 + col0) = pk; }
    }
};
struct EpiDownScatter {
    static constexpr bool PERM = false, AFTER_DRAIN = false;
    float* out; const int* list; float* ssqp;
    __device__ __forceinline__ void operator()(const f32x4 (&acc)[2][2][4][2], const Unit& u, int wr, int wc, int fr, int fq) const {
        const int col0 = u.pn * BM + wc * 32 + 4 * fq;
#pragma unroll
        for (int ai = 0; ai < 2; ++ai)
#pragma unroll
            for (int m = 0; m < 4; ++m) { const int rl = ai * HALF + wr * 64 + m * 16 + fr; const bool ok = rl < u.nrows; const int tok = list[u.pm * BM + rl];
                float* rowp = out + (size_t)tok * 1024 + col0; float ss = 0.f;
#pragma unroll
                for (int bj = 0; bj < 2; ++bj)
#pragma unroll
                    for (int n = 0; n < 2; ++n) { const f32x4 r = *(const f32x4*)(rowp + bj * HALF + n * 16); const f32x4 v = acc[ai][bj][m][n] + r;
                        ss += (v[0] * v[0] + v[1] * v[1]) + (v[2] * v[2] + v[3] * v[3]); if (ok) *(f32x4*)(rowp + bj * HALF + n * 16) = v; }
                ss += __shfl_xor(ss, 16); ss += __shfl_xor(ss, 32);
                if (ok && fq == 0) ssqp[(size_t)tok * 16 + 4 * u.pn + wc] = ss;
                if (m & 1) asm volatile("" ::: "memory"); }
    }
};
struct EpiRowScaleBf16 {
    static constexpr bool PERM = true, AFTER_DRAIN = false;
    bf16_t* O; int ldc; const float* rs;
    __device__ __forceinline__ void operator()(const f32x4 (&acc)[2][2][4][2], const Unit& u, int wr, int wc, int fr, int fq) const {
        const int row0 = u.pm * BM + wr * 64 + fr, col0 = u.pn * BM + wc * 32 + 8 * fq;
#pragma unroll
        for (int ai = 0; ai < 2; ++ai)
#pragma unroll
            for (int m = 0; m < 4; ++m) { const int row = row0 + ai * HALF + m * 16; const float s = rs[row]; bf16_t* rowp = O + (size_t)row * ldc + col0;
#pragma unroll
                for (int bj = 0; bj < 2; ++bj) { const f32x4 v0 = acc[ai][bj][m][0] * s, v1 = acc[ai][bj][m][1] * s;
                    u32x4 w; w.x = cvt_pk_bf16(v0[0], v0[1]); w.y = cvt_pk_bf16(v0[2], v0[3]); w.z = cvt_pk_bf16(v1[0], v1[1]); w.w = cvt_pk_bf16(v1[2], v1[3]);
                    *(u32x4*)(rowp + bj * HALF) = w; } }
    }
};
}
#define PG8_SP2 true
#define PG8_ALIGN true
#define XB_TMO      128
#define XB_XCNT(j)  (256  + 64 * (j))
#define XB_XSUB(j)  (1280 + 64 * (j))
#define XB_XGEN(j)  (2304 + 64 * (j))
#define XB_TOP      3328
#define XB_TOPGEN   3392
#define XCD_BAR_WORDS 3456
#define XB_SPIN_CAP (1u << 18)

__device__ __forceinline__ unsigned xb_ld(unsigned* p)              { return __hip_atomic_load(p, __ATOMIC_RELAXED, __HIP_MEMORY_SCOPE_AGENT); }
__device__ __forceinline__ unsigned xb_add(unsigned* p, unsigned v) { return __hip_atomic_fetch_add(p, v, __ATOMIC_RELAXED, __HIP_MEMORY_SCOPE_AGENT); }
__device__ __forceinline__ unsigned xb_xcc_id() { return (unsigned)__builtin_amdgcn_s_getreg((3 << 11) | 20) & 0xFu; }
#define XB_SPIN(cond, bar) do { unsigned _sp = 0; while (cond) { __builtin_amdgcn_s_sleep(1); \
    if ((++_sp & 255u) == 0u) { if (xb_ld(&(bar)[XB_TMO])) break; if (_sp > XB_SPIN_CAP) { atomicAdd(&(bar)[XB_TMO], 1u); break; } } } } while (0)

struct XcdBarrier {
    unsigned* bar; unsigned x;
    volatile LAS unsigned* st;
};

__device__ __forceinline__ XcdBarrier xcd_barrier_post(unsigned* bar, volatile LAS unsigned* st) {
    XcdBarrier b; b.bar = bar; b.x = xb_xcc_id(); b.st = st;
    if (threadIdx.x == 0) (void)xb_add(&bar[XB_XCNT(b.x)], 1u);
    return b;
}
__device__ __forceinline__ void xcd_barrier_complete(unsigned* bar, unsigned x, unsigned& nloc, unsigned& nx) {
    const unsigned G = gridDim.x * gridDim.y * gridDim.z;
    unsigned sum, cnt, mine, sp = 0u;
    for (;;) {
        sum = 0u; cnt = 0u; mine = 0u;
#pragma unroll
        for (unsigned j = 0; j < 16; ++j) { const unsigned c = xb_ld(&bar[XB_XCNT(j)]); sum += c; cnt += (c > 0u) ? 1u : 0u; mine = (j == x) ? c : mine; }
        if (sum == G) break;
        __builtin_amdgcn_s_sleep(1);
        if ((++sp & 255u) == 0u) { if (xb_ld(&bar[XB_TMO])) break; if (sp > XB_SPIN_CAP) { atomicAdd(&bar[XB_TMO], 1u); break; } }
    }
    nloc = mine > 0u ? mine : 1u; nx = cnt > 0u ? cnt : 1u;
}

__device__ __forceinline__ void xcd_barrier(const XcdBarrier& b) {
    asm volatile("s_waitcnt vmcnt(0)" ::: "memory");
    __syncthreads();
    if (threadIdx.x == 0) {
        unsigned* bar = b.bar;
        __builtin_amdgcn_s_waitcnt(0);
        unsigned nloc = b.st[0], nx = b.st[1];
        if (nloc == 0u) { xcd_barrier_complete(bar, b.x, nloc, nx); b.st[0] = nloc; b.st[1] = nx; }
        const unsigned old = xb_add(&bar[XB_XSUB(b.x)], 1u);
        const unsigned gen = old / nloc;
        if (old + 1u == (gen + 1u) * nloc) {
            __builtin_amdgcn_fence(__ATOMIC_RELEASE, "agent");
            asm volatile("s_waitcnt vmcnt(0)" ::: "memory");
            const unsigned og = xb_add(&bar[XB_TOP], 1u);
            const unsigned tg = og / nx;
            if (og + 1u == (tg + 1u) * nx) xb_add(&bar[XB_TOPGEN], 1u);
            else XB_SPIN(xb_ld(&bar[XB_TOPGEN]) == tg, bar);
            __builtin_amdgcn_fence(__ATOMIC_ACQUIRE, "agent");
            xb_add(&bar[XB_XGEN(b.x)], 1u);
            asm volatile("s_waitcnt vmcnt(0)" ::: "memory");
        } else {
            XB_SPIN(xb_ld(&bar[XB_XGEN(b.x)]) == gen, bar);
            __builtin_amdgcn_fence(__ATOMIC_ACQUIRE, "agent");
            asm volatile("s_waitcnt vmcnt(0)" ::: "memory");
        }
    }
    __syncthreads();
}
typedef short s16x8 __attribute__((ext_vector_type(8)));
typedef float f32x16 __attribute__((ext_vector_type(16)));
typedef unsigned u32x2 __attribute__((ext_vector_type(2)));
__device__ __forceinline__ f32x16 mfma32(s16x8 a, s16x8 b, f32x16 c) { return __builtin_amdgcn_mfma_f32_32x32x16_bf16(a, b, c, 0, 0, 0); }
__device__ __forceinline__ s16x8 pack8(float a0, float a1, float a2, float a3, float a4, float a5, float a6, float a7) {
    v4u w; w.x = pk2(a0, a1); w.y = pk2(a2, a3); w.z = pk2(a4, a5); w.w = pk2(a6, a7); return __builtin_bit_cast(s16x8, w); }
__device__ __forceinline__ int rho(int t, int h2, int j) { return 16 * t + 8 * (j >> 2) + 4 * h2 + (j & 3); }

constexpr size_t DS_UNIT = 128 * 64;
constexpr size_t WS_DECAY = WS_DS + (size_t)16 * 128 * DS_UNIT * 2;
constexpr size_t WS_DSMETA = WS_DECAY + (size_t)16 * 128 * 64 * 4;
static_assert(WS_DSMETA + 4 * DS_UNIT * 4 <= WS_SS, "ds region");
static_assert(WS_SS + (size_t)16 * 128 * DS_UNIT * 2 <= WS_XS, "ss region");

__device__ __forceinline__ void gla_gate(const float* glr_rows, const float* wgu, const float* bg, int h, int lane, s16x8 (&laH)[2][2][2], s16x8 (&laL)[2][2][2]) {
    const int l31 = lane & 31, h2 = lane >> 5;
    s16x8 Wf[2];
#pragma unroll
    for (int Db = 0; Db < 2; ++Db) { const float* wp = wgu + (8 * h2) * 256 + h * 64 + 32 * Db + l31;
        Wf[Db] = pack8(wp[0], wp[256], wp[512], wp[768], wp[1024], wp[1280], wp[1536], wp[1792]); }
#pragma unroll
    for (int T = 0; T < 2; ++T) {
        const f32x4* gp = (const f32x4*)(glr_rows + (32 * T + l31) * 16 + 8 * h2); const f32x4 g0 = gp[0], g1 = gp[1];
        const s16x8 Gf = pack8(g0.x, g0.y, g0.z, g0.w, g1.x, g1.y, g1.z, g1.w);
#pragma unroll
        for (int Db = 0; Db < 2; ++Db) {
            const float bias = bg[h * 64 + 32 * Db + l31]; f32x16 acc;
#pragma unroll
            for (int r = 0; r < 16; ++r) acc[r] = bias;
            acc = mfma32(Gf, Wf[Db], acc);
            float hi[16], lo[16];
#pragma unroll
            for (int r = 0; r < 16; ++r) { const float z = acc[r]; const float la = (fminf(z, 0.f) - __logf(1.f + __expf(-fabsf(z)))) * 0.0625f;
                const float hf = __uint_as_float(f2bf(la) << 16); hi[r] = hf; lo[r] = la - hf; }
#pragma unroll
            for (int t = 0; t < 2; ++t) { laH[T][Db][t] = pack8(hi[8 * t], hi[8 * t + 1], hi[8 * t + 2], hi[8 * t + 3], hi[8 * t + 4], hi[8 * t + 5], hi[8 * t + 6], hi[8 * t + 7]);
                                          laL[T][Db][t] = pack8(lo[8 * t], lo[8 * t + 1], lo[8 * t + 2], lo[8 * t + 3], lo[8 * t + 4], lo[8 * t + 5], lo[8 * t + 6], lo[8 * t + 7]); }
        }
    }
}
__device__ __forceinline__ void tri_frags(int lane, s16x8 (&tri)[2], s16x8& ones) {
    const int l31 = lane & 31, h2 = lane >> 5;
#pragma unroll
    for (int t = 0; t < 2; ++t) { s16x8 f;
#pragma unroll
        for (int j = 0; j < 8; ++j) f[j] = (rho(t, h2, j) <= l31) ? (short)0x3F80 : (short)0;
        tri[t] = f; }
#pragma unroll
    for (int j = 0; j < 8; ++j) ones[j] = (short)0x3F80;
}
__device__ __forceinline__ s16x8 load_vfrag(const bf16* vcol, int T, int t, int h2) {
    s16x8 f;
#pragma unroll
    for (int j = 0; j < 8; ++j) f[j] = (short)vcol[(size_t)(32 * T + rho(t, h2, j)) * PC];
    return f;
}

__device__ __forceinline__ void gla_pass1_unit(const Args& a, int unit, int lane) {
    asm volatile("" : "+v"(lane));
    unsigned char* ws = a.ws;
    const int bh = unit >> 7, nm1 = unit & 127, b = bh >> 2, h = bh & 3, l31 = lane & 31, h2 = lane >> 5;
    const int m0 = b * SEQ + 64 * nm1;
    const bf16* proj = (const bf16*)(ws + WS_PROJ);
    s16x8 laH[2][2][2], laL[2][2][2];
    gla_gate((const float*)(ws + WS_GLR) + (size_t)m0 * 16, a.in[4], a.in[5], h, lane, laH, laL);
    s16x8 tri[2], ones; tri_frags(lane, tri, ones);
    f32x16 bA[2][2];
#pragma unroll
    for (int T = 0; T < 2; ++T)
#pragma unroll
        for (int Db = 0; Db < 2; ++Db) { f32x16 acc;
#pragma unroll
            for (int r = 0; r < 16; ++r) acc[r] = 0.f;
#pragma unroll
            for (int Ts = 0; Ts <= T; ++Ts)
#pragma unroll
                for (int t = 0; t < 2; ++t) { const s16x8 Lf = (Ts == T) ? tri[t] : ones; acc = mfma32(Lf, laH[Ts][Db][t], acc); acc = mfma32(Lf, laL[Ts][Db][t], acc); }
            bA[T][Db] = acc; }
    float blast[2];
#pragma unroll
    for (int Db = 0; Db < 2; ++Db) blast[Db] = __shfl(bA[1][Db][15], l31 + 32);
    if (h2 == 0) { float* dec = (float*)(ws + WS_DECAY) + (size_t)unit * 64; dec[l31] = __expf(blast[0]); dec[32 + l31] = __expf(blast[1]); }
    s16x8 ke[2][2][2];
#pragma unroll
    for (int Db = 0; Db < 2; ++Db) { const bf16* kcol = proj + (size_t)m0 * PC + C_K + h * 64 + 32 * Db + l31;
#pragma unroll
        for (int T = 0; T < 2; ++T)
#pragma unroll
            for (int t = 0; t < 2; ++t) { float kv[8];
#pragma unroll
                for (int j = 0; j < 8; ++j) kv[j] = bf2f(kcol[(size_t)(32 * T + rho(t, h2, j)) * PC]) * __expf(blast[Db] - bA[T][Db][8 * t + j]);
                ke[Db][T][t] = pack8(kv[0], kv[1], kv[2], kv[3], kv[4], kv[5], kv[6], kv[7]); } }
    bf16* dS = (bf16*)(ws + WS_DS) + (size_t)unit * DS_UNIT;
#pragma unroll 1
    for (int Vb = 0; Vb < 4; ++Vb) {
        const bf16* vcol = proj + (size_t)m0 * PC + C_V + h * 128 + 32 * Vb + l31;
        f32x16 acc0, acc1;
#pragma unroll
        for (int r = 0; r < 16; ++r) { acc0[r] = 0.f; acc1[r] = 0.f; }
#pragma unroll
        for (int T = 0; T < 2; ++T)
#pragma unroll
            for (int t = 0; t < 2; ++t) { const s16x8 Vf = load_vfrag(vcol, T, t, h2); acc0 = mfma32(ke[0][T][t], Vf, acc0); acc1 = mfma32(ke[1][T][t], Vf, acc1); }
        bf16* row = dS + (size_t)(32 * Vb + l31) * 64;
#pragma unroll
        for (int i = 0; i < 4; ++i) { u32x2 w0, w1; w0.x = pk2(acc0[4 * i], acc0[4 * i + 1]); w0.y = pk2(acc0[4 * i + 2], acc0[4 * i + 3]); w1.x = pk2(acc1[4 * i], acc1[4 * i + 1]); w1.y = pk2(acc1[4 * i + 2], acc1[4 * i + 3]);
            *(u32x2*)(row + 8 * i + 4 * h2) = w0; *(u32x2*)(row + 32 + 8 * i + 4 * h2) = w1; }
    }
}
__device__ __forceinline__ void gla_meta_unit(const Args& a, int mu, int lane) {
    const int h = mu >> 3, vs = mu & 7, d = lane;
    const float* mproj = (const float*)(a.ws + WS_MPROJ); const float* wgu = a.in[4]; const float* bg = a.in[5];
    float w[16];
#pragma unroll
    for (int r = 0; r < 16; ++r) w[r] = wgu[r * 256 + h * 64 + d];
    float bs[16], run = 0.f;
#pragma unroll
    for (int s = 0; s < 16; ++s) { float z = bg[h * 64 + d];
#pragma unroll
        for (int r = 0; r < 16; ++r) z += mproj[s * INC + C_G + r] * w[r];
        run += (fminf(z, 0.f) - log1pf(expf(-fabsf(z)))) * 0.0625f; bs[s] = run; }
    float ke[16];
#pragma unroll
    for (int s = 0; s < 16; ++s) ke[s] = mproj[s * INC + C_K + h * 64 + d] * expf(bs[15] - bs[s]);
    float* out = (float*)(a.ws + WS_DSMETA) + (size_t)h * DS_UNIT;
#pragma unroll 4
    for (int vv = 0; vv < 16; ++vv) { const int v = 16 * vs + vv; float acc = 0.f;
#pragma unroll
        for (int s = 0; s < 16; ++s) acc += ke[s] * mproj[s * INC + C_V + h * 128 + v];
        out[v * 64 + d] = acc; }
}
__device__ __forceinline__ void gla_scan(const Args& a, int gtid, int gthreads) {
    unsigned char* ws = a.ws;
    for (int id = gtid; id < 16 * 128 * 16; id += gthreads) {
        const int bh = id >> 11, v = (id >> 4) & 127, d4 = (id & 15) * 4, h = bh & 3;
        const f32x4 s0 = *(const f32x4*)((const float*)(ws + WS_DSMETA) + (size_t)h * DS_UNIT + v * 64 + d4);
        float S0 = s0.x, S1 = s0.y, S2 = s0.z, S3 = s0.w;
        const bf16* dS = (const bf16*)(ws + WS_DS) + (size_t)bh * 128 * DS_UNIT + v * 64 + d4;
        bf16* SS = (bf16*)(ws + WS_SS) + (size_t)bh * 128 * DS_UNIT + v * 64 + d4;
        const float* dec = (const float*)(ws + WS_DECAY) + (size_t)bh * 128 * 64 + d4;
#pragma unroll 1
        for (int n0 = 0; n0 < 128; n0 += 16) {
            u32x2 dv[16]; f32x4 dc[16];
#pragma unroll
            for (int i = 0; i < 16; ++i) { dv[i] = *(const u32x2*)(dS + (size_t)(n0 + i) * DS_UNIT); dc[i] = *(const f32x4*)(dec + (size_t)(n0 + i) * 64); }
#pragma unroll
            for (int i = 0; i < 16; ++i) {
                u32x2 o; o.x = pk2(S0, S1); o.y = pk2(S2, S3); *(u32x2*)(SS + (size_t)(n0 + i) * DS_UNIT) = o;
                S0 = dc[i].x * S0 + __uint_as_float(dv[i].x << 16); S1 = dc[i].y * S1 + __uint_as_float(dv[i].x & 0xffff0000u);
                S2 = dc[i].z * S2 + __uint_as_float(dv[i].y << 16); S3 = dc[i].w * S3 + __uint_as_float(dv[i].y & 0xffff0000u);
            }
        }
    }
}
__device__ __forceinline__ void gla_pass2_unit(const Args& a, int unit, int lane) {
    asm volatile("" : "+v"(lane));
    unsigned char* ws = a.ws;
    const int bh = unit >> 7, nm1 = unit & 127, b = bh >> 2, h = bh & 3, l31 = lane & 31, h2 = lane >> 5;
    const int m0 = b * SEQ + 64 * nm1;
    const bf16* proj = (const bf16*)(ws + WS_PROJ);
    s16x8 qt[2][4], kt[2][4];
    {
        s16x8 laH[2][2][2], laL[2][2][2];
        gla_gate((const float*)(ws + WS_GLR) + (size_t)m0 * 16, a.in[4], a.in[5], h, lane, laH, laL);
        s16x8 tri[2], ones; tri_frags(lane, tri, ones);
#pragma unroll
        for (int T = 0; T < 2; ++T)
#pragma unroll
            for (int Db = 0; Db < 2; ++Db) {
                f32x16 acc;
#pragma unroll
                for (int r = 0; r < 16; ++r) acc[r] = 0.f;
#pragma unroll
                for (int Ts = 0; Ts <= T; ++Ts)
#pragma unroll
                    for (int t = 0; t < 2; ++t) { const s16x8 Uf = (Ts == T) ? tri[t] : ones; acc = mfma32(laH[Ts][Db][t], Uf, acc); acc = mfma32(laL[Ts][Db][t], Uf, acc); }
                asm volatile("" ::: "memory");
                const bf16* qrow = proj + (size_t)(m0 + 32 * T + l31) * PC + C_Q + h * 64; const bf16* krow = qrow + (C_K - C_Q);
#pragma unroll
                for (int t = 0; t < 2; ++t) { const int ks = 2 * Db + t;
                    const u32x2 q0 = *(const u32x2*)(qrow + 16 * ks + 4 * h2), q1 = *(const u32x2*)(qrow + 16 * ks + 8 + 4 * h2);
                    const u32x2 k0 = *(const u32x2*)(krow + 16 * ks + 4 * h2), k1 = *(const u32x2*)(krow + 16 * ks + 8 + 4 * h2);
                    float e[8], qf[8], kf[8];
#pragma unroll
                    for (int j = 0; j < 8; ++j) e[j] = __expf(acc[8 * t + j]);
                    qf[0] = __uint_as_float(q0.x << 16); qf[1] = __uint_as_float(q0.x & 0xffff0000u); qf[2] = __uint_as_float(q0.y << 16); qf[3] = __uint_as_float(q0.y & 0xffff0000u);
                    qf[4] = __uint_as_float(q1.x << 16); qf[5] = __uint_as_float(q1.x & 0xffff0000u); qf[6] = __uint_as_float(q1.y << 16); qf[7] = __uint_as_float(q1.y & 0xffff0000u);
                    kf[0] = __uint_as_float(k0.x << 16); kf[1] = __uint_as_float(k0.x & 0xffff0000u); kf[2] = __uint_as_float(k0.y << 16); kf[3] = __uint_as_float(k0.y & 0xffff0000u);
                    kf[4] = __uint_as_float(k1.x << 16); kf[5] = __uint_as_float(k1.x & 0xffff0000u); kf[6] = __uint_as_float(k1.y << 16); kf[7] = __uint_as_float(k1.y & 0xffff0000u);
#pragma unroll
                    for (int j = 0; j < 8; ++j) { qf[j] = qf[j] * 0.125f * e[j]; kf[j] = kf[j] * __builtin_amdgcn_rcpf(e[j]); }
                    qt[T][ks] = pack8(qf[0], qf[1], qf[2], qf[3], qf[4], qf[5], qf[6], qf[7]);
                    kt[T][ks] = pack8(kf[0], kf[1], kf[2], kf[3], kf[4], kf[5], kf[6], kf[7]); }
            }
    }
    const bf16* St = (const bf16*)(ws + WS_SS) + (size_t)unit * DS_UNIT;
    const float* gnw = a.in[6];
    bf16* ymix = (bf16*)(ws + WS_YMIX);
#pragma unroll
    for (int C = 0; C < 2; ++C) {
        f32x16 Y[4];
#pragma unroll
        for (int Vb = 0; Vb < 4; ++Vb)
#pragma unroll
            for (int r = 0; r < 16; ++r) Y[Vb][r] = 0.f;
#pragma unroll
        for (int S = 0; S < 2; ++S) {
            if (S <= C) {
                f32x16 sc;
#pragma unroll
                for (int r = 0; r < 16; ++r) sc[r] = 0.f;
#pragma unroll
                for (int ks = 0; ks < 4; ++ks) sc = mfma32(kt[S][ks], qt[C][ks], sc);
                if (S == C) {
#pragma unroll
                    for (int r = 0; r < 16; ++r) { const int sl = (r & 3) + 8 * (r >> 2) + 4 * h2; if (sl > l31) sc[r] = 0.f; }
                }
                s16x8 P[2];
#pragma unroll
                for (int t = 0; t < 2; ++t) P[t] = pack8(sc[8 * t], sc[8 * t + 1], sc[8 * t + 2], sc[8 * t + 3], sc[8 * t + 4], sc[8 * t + 5], sc[8 * t + 6], sc[8 * t + 7]);
#pragma unroll
                for (int Vb = 0; Vb < 4; ++Vb) { const bf16* vcol = proj + (size_t)m0 * PC + C_V + h * 128 + 32 * Vb + l31;
#pragma unroll
                    for (int t = 0; t < 2; ++t) { const s16x8 Vf = load_vfrag(vcol, S, t, h2); Y[Vb] = mfma32(Vf, P[t], Y[Vb]); }
                    asm volatile("" ::: "memory"); }
            }
        }
#pragma unroll
        for (int Vb = 0; Vb < 4; ++Vb) { const bf16* srow = St + (size_t)(32 * Vb + l31) * 64;
#pragma unroll
            for (int ks = 0; ks < 4; ++ks) { const u32x2 s0 = *(const u32x2*)(srow + 16 * ks + 4 * h2), s1 = *(const u32x2*)(srow + 16 * ks + 8 + 4 * h2);
                v4u w; w.x = s0.x; w.y = s0.y; w.z = s1.x; w.w = s1.y; Y[Vb] = mfma32(__builtin_bit_cast(s16x8, w), qt[C][ks], Y[Vb]); }
            asm volatile("" ::: "memory"); }
        float ss = 0.f;
#pragma unroll
        for (int Vb = 0; Vb < 4; ++Vb)
#pragma unroll
            for (int r = 0; r < 16; ++r) ss += Y[Vb][r] * Y[Vb][r];
        ss += __shfl_xor(ss, 32);
        const float rs = rsqrtf(ss * (1.f / 128.f) + EPS);
        const int m = m0 + 32 * C + l31;
        const bf16* rrow = proj + (size_t)m * PC + C_R + h * 128; bf16* orow = ymix + (size_t)m * D + 512 + h * 128;
#pragma unroll
        for (int Vb = 0; Vb < 4; ++Vb) {
            asm volatile("" ::: "memory");
#pragma unroll
            for (int i = 0; i < 4; ++i) { const int v = 32 * Vb + 8 * i + 4 * h2;
                const u32x2 rr = *(const u32x2*)(rrow + v); const f32x4 gw = *(const f32x4*)(gnw + v);
                const float r0 = __uint_as_float(rr.x << 16), r1 = __uint_as_float(rr.x & 0xffff0000u), r2 = __uint_as_float(rr.y << 16), r3 = __uint_as_float(rr.y & 0xffff0000u);
                const float o0 = Y[Vb][4 * i] * rs * gw.x * (r0 / (1.f + __expf(-r0))), o1 = Y[Vb][4 * i + 1] * rs * gw.y * (r1 / (1.f + __expf(-r1)));
                const float o2 = Y[Vb][4 * i + 2] * rs * gw.z * (r2 / (1.f + __expf(-r2))), o3 = Y[Vb][4 * i + 3] * rs * gw.w * (r3 / (1.f + __expf(-r3)));
                u32x2 w; w.x = pk2(o0, o1); w.y = pk2(o2, o3); *(u32x2*)(orow + v) = w; }
        }
    }
}
template <int W>
__device__ __forceinline__ void pool_fill(const bf16* proj, const float* mproj, int b, int s0, int g, int lane, LAS unsigned char* tile) {
    auto ld = [&](int s, float& x0, float& x1) {
        if (s >= 0) { const unsigned u = *(const unsigned*)(proj + (size_t)(b * SEQ + s) * PC + g * 128 + 2 * lane); x0 = __uint_as_float(u << 16); x1 = __uint_as_float(u & 0xffff0000u); }
        else { const float* p = mproj + (NMETA + s) * INC + g * 128 + 2 * lane; x0 = p[0]; x1 = p[1]; } };
    float w0 = 0.f, w1 = 0.f, x0, x1;
#pragma unroll
    for (int j = 1; j < W; ++j) { ld(s0 - j, x0, x1); w0 += x0; w1 += x1; }
    constexpr float inv = 1.f / W;
#pragma unroll 4
    for (int tok = 0; tok < 64; ++tok) {
        ld(s0 + tok, x0, x1); w0 += x0; w1 += x1;
        const float p0 = w0 * inv - x0, p1 = w1 * inv - x1;
        *(LAS unsigned*)(tile + tok * 256 + ((4 * lane) ^ ((tok & 15) << 4))) = pk2(p0, p1);
        float y0, y1; ld(s0 + tok - (W - 1), y0, y1); w0 -= y0; w1 -= y1;
    }
}
__device__ __forceinline__ void pool_unit(const Args& a, int unit, int lane, LAS unsigned char* tile) {
    asm volatile("" : "+v"(lane));
    unsigned char* ws = a.ws;
    const int tt = unit >> 2, g = unit & 3, m0 = 64 * tt, b = m0 / SEQ, s0 = m0 % SEQ, l31 = lane & 31, h2 = lane >> 5;
    const bf16* proj = (const bf16*)(ws + WS_PROJ); const float* mproj = (const float*)(ws + WS_MPROJ);
    if (g == 0) pool_fill<2>(proj, mproj, b, s0, g, lane, tile); else if (g == 1) pool_fill<4>(proj, mproj, b, s0, g, lane, tile);
    else if (g == 2) pool_fill<8>(proj, mproj, b, s0, g, lane, tile); else pool_fill<16>(proj, mproj, b, s0, g, lane, tile);
    LDS_WAIT(); asm volatile("" ::: "memory");
    s16x8 Pf[2][8];
#pragma unroll
    for (int T = 0; T < 2; ++T) { const int tok = 32 * T + l31;
#pragma unroll
        for (int ks = 0; ks < 8; ++ks) Pf[T][ks] = *(const LAS s16x8*)(tile + tok * 256 + ((32 * ks + 16 * h2) ^ ((tok & 15) << 4))); }
    LDS_WAIT(); asm volatile("" ::: "memory");
    const bf16* wt = (const bf16*)(ws + WS_POOLW) + g * 16384; const float* psc = a.in[8] + g * 128;
#pragma unroll 1
    for (int Nb = 0; Nb < 4; ++Nb) {
        f32x16 acc0, acc1;
#pragma unroll
        for (int r = 0; r < 16; ++r) { acc0[r] = 0.f; acc1[r] = 0.f; }
        const bf16* wrow = wt + (size_t)(32 * Nb + l31) * 128 + 8 * h2;
#pragma unroll
        for (int ks = 0; ks < 8; ++ks) { const s16x8 Wf = *(const s16x8*)(wrow + 16 * ks); acc0 = mfma32(Wf, Pf[0][ks], acc0); acc1 = mfma32(Wf, Pf[1][ks], acc1); }
#pragma unroll
        for (int i = 0; i < 4; ++i) { const int d = 32 * Nb + 8 * i + 4 * h2; const f32x4 sc = *(const f32x4*)(psc + d);
            u32x2 w0, w1; w0.x = pk2(acc0[4 * i] * sc.x, acc0[4 * i + 1] * sc.y); w0.y = pk2(acc0[4 * i + 2] * sc.z, acc0[4 * i + 3] * sc.w);
            w1.x = pk2(acc1[4 * i] * sc.x, acc1[4 * i + 1] * sc.y); w1.y = pk2(acc1[4 * i + 2] * sc.z, acc1[4 * i + 3] * sc.w);
            const int t0 = l31, t1 = 32 + l31;
            *(LAS u32x2*)(tile + t0 * 256 + ((2 * d) ^ ((t0 & 15) << 4))) = w0; *(LAS u32x2*)(tile + t1 * 256 + ((2 * d) ^ ((t1 & 15) << 4))) = w1; }
    }
    LDS_WAIT(); asm volatile("" ::: "memory");
    bf16* ymix = (bf16*)(ws + WS_YMIX);
#pragma unroll
    for (int it = 0; it < 16; ++it) { const int row = 4 * it + (lane >> 4), ch = lane & 15;
        const v4u v = *(const LAS v4u*)(tile + row * 256 + ((ch ^ (row & 15)) << 4));
        *(v4u*)(ymix + (size_t)(m0 + row) * D + g * 128 + ch * 8) = v; }
    LDS_WAIT(); asm volatile("" ::: "memory");
}
constexpr size_t RT_CLS = WS_ROUTE, RT_RANK = WS_ROUTE + 128 * 1024, RT_W = WS_ROUTE + 256 * 1024, RT_BCNT = WS_ROUTE + 512 * 1024,
                 RT_LIST = WS_ROUTE + 1 * MiB, RT_WS = WS_ROUTE + 1 * MiB + 512 * 1024, RT_SSQ = WS_ROUTE + 2 * MiB;
constexpr int HROWS = 38912;
static_assert(RT_SSQ + (size_t)TR * 16 * 4 <= WS_A0 && (size_t)HROWS * 512 * 2 <= WS_END - WS_H, "moe ws");
constexpr int LC_OFF = LDSCTL_OFF + 512, LC_TOT = LDSCTL_OFF + 640, LC_NT = LDSCTL_OFF + 760, LC_TCLS = LDSCTL_OFF + 1024;

__device__ __forceinline__ void p6_route(const Args& a, LAS unsigned char* lds, int vcu, int G) {
    const int tid = threadIdx.x, lane = tid & 63, wave = __builtin_amdgcn_readfirstlane(tid >> 6);
    unsigned char* ws = a.ws;
    LAS float* wr_t = (LAS float*)lds;
    LAS float* lgs = (LAS float*)(lds + 81920) + wave * 64;
    LAS int* bcls = (LAS int*)(lds + 81920 + 2048);
    { const float* nfw = a.in[10]; const float* wrg = a.in[11]; const float* wre = a.in[13];
      for (int i = tid; i < 4096; i += 512) { const int k = i >> 2, j = i & 3; wr_t[j * 1024 + k] = nfw[k] * wrg[i]; }
      for (int i = tid; i < 16384; i += 512) { const int k = i >> 4, e = i & 15; wr_t[(4 + e) * 1024 + k] = nfw[k] * wre[i]; } }
    __syncthreads();
    const float* brg = a.in[12]; const float* bre = a.in[14];
    int* rt_cls = (int*)(ws + RT_CLS); int* rt_rank = (int*)(ws + RT_RANK); float* rt_w = (float*)(ws + RT_W); int* bcnt = (int*)(ws + RT_BCNT);
    bf16* xn2 = (bf16*)(ws + WS_A0);
    for (int blk = vcu; blk < TR / 128; blk += G) {
#pragma unroll 1
        for (int it = 0; it < 8; ++it) {
            const int m = 128 * blk + 16 * wave + 2 * it;
            const GAS f32x4* x0 = (const GAS f32x4*)(a.out + (size_t)m * D) + lane; const GAS f32x4* x1 = x0 + D / 4;
            f32x4 v0[4], v1[4]; float s0 = 0.f, s1 = 0.f;
#pragma unroll
            for (int j = 0; j < 4; ++j) { v0[j] = x0[64 * j]; v1[j] = x1[64 * j]; }
#pragma unroll
            for (int j = 0; j < 4; ++j) { s0 += (v0[j].x * v0[j].x + v0[j].y * v0[j].y) + (v0[j].z * v0[j].z + v0[j].w * v0[j].w); s1 += (v1[j].x * v1[j].x + v1[j].y * v1[j].y) + (v1[j].z * v1[j].z + v1[j].w * v1[j].w); }
            s0 = wave_sum(s0); s1 = wave_sum(s1);
            const float r0 = rsqrtf(s0 * (1.f / D) + EPS), r1 = rsqrtf(s1 * (1.f / D) + EPS);
            GAS unsigned long long* o0 = (GAS unsigned long long*)(xn2 + (size_t)m * D) + lane; GAS unsigned long long* o1 = o0 + D / 4;
#pragma unroll
            for (int j = 0; j < 4; ++j) { o0[64 * j] = (unsigned long long)pk2(v0[j].x * r0, v0[j].y * r0) | ((unsigned long long)pk2(v0[j].z * r0, v0[j].w * r0) << 32);
                                          o1[64 * j] = (unsigned long long)pk2(v1[j].x * r1, v1[j].y * r1) | ((unsigned long long)pk2(v1[j].z * r1, v1[j].w * r1) << 32); }
            float ac[64];
#pragma unroll
            for (int q = 0; q < 64; ++q) ac[q] = 0.f;
#pragma unroll
            for (int q = 0; q < 20; ++q) { float t0 = 0.f, t1 = 0.f;
#pragma unroll
                for (int j = 0; j < 4; ++j) { const f32x4 w4 = *(const LAS f32x4*)(wr_t + q * 1024 + 4 * lane + 256 * j);
                    t0 += (v0[j].x * w4.x + v0[j].y * w4.y) + (v0[j].z * w4.z + v0[j].w * w4.w); t1 += (v1[j].x * w4.x + v1[j].y * w4.y) + (v1[j].z * w4.z + v1[j].w * w4.w); }
                ac[q] = t0; ac[32 + q] = t1; if (q & 1) asm volatile("" ::: "memory"); }
            float b32[32], b16[16], b8[8], b4[4], b2[2];
            { const bool hi = lane & 32;
#pragma unroll
              for (int i = 0; i < 32; ++i) { if ((i & 31) < 20) { const float keep = hi ? ac[32 + i] : ac[i], send = hi ? ac[i] : ac[32 + i]; b32[i] = keep + __shfl_xor(send, 32); } else b32[i] = 0.f; } }
            { const bool hi = lane & 16;
#pragma unroll
              for (int i = 0; i < 16; ++i) { const float keep = hi ? b32[16 + i] : b32[i], send = hi ? b32[i] : b32[16 + i]; b16[i] = keep + __shfl_xor(send, 16); } }
            { const bool hi = lane & 8;
#pragma unroll
              for (int i = 0; i < 8; ++i) { const float keep = hi ? b16[8 + i] : b16[i], send = hi ? b16[i] : b16[8 + i]; b8[i] = keep + __shfl_xor(send, 8); } }
            { const bool hi = lane & 4;
#pragma unroll
              for (int i = 0; i < 4; ++i) { const float keep = hi ? b8[4 + i] : b8[i], send = hi ? b8[i] : b8[4 + i]; b4[i] = keep + __shfl_xor(send, 4); } }
            { const bool hi = lane & 2;
#pragma unroll
              for (int i = 0; i < 2; ++i) { const float keep = hi ? b4[2 + i] : b4[i], send = hi ? b4[i] : b4[2 + i]; b2[i] = keep + __shfl_xor(send, 2); } }
            float b1; { const bool hi = lane & 1; const float keep = hi ? b2[1] : b2[0], send = hi ? b2[0] : b2[1]; b1 = keep + __shfl_xor(send, 1); }
            { const int rw = lane >> 5, j = lane & 31; const float bias = j < 4 ? brg[j] : (j < 20 ? bre[j - 4] : 0.f); lgs[lane] = b1 * (rw ? r1 : r0) + bias; }
            LDS_WAIT(); asm volatile("" ::: "memory");
            if ((lane & 31) == 0) {
                const int rw = lane >> 5; const LAS float* lg = lgs + 32 * rw;
                const float g0 = lg[0], g1 = lg[1], g2 = lg[2], g3 = lg[3];
                int g = 0; float gm = g0; if (g1 > gm) { gm = g1; g = 1; } if (g2 > gm) { gm = g2; g = 2; } if (g3 > gm) { gm = g3; g = 3; }
                const float pg = 1.f / (expf(g0 - gm) + expf(g1 - gm) + expf(g2 - gm) + expf(g3 - gm));
                const LAS float* el = lg + 4 + 4 * g; const float e0 = el[0], e1 = el[1], e2 = el[2], e3 = el[3];
                int i1 = 0; float m1 = e0; if (e1 > m1) { m1 = e1; i1 = 1; } if (e2 > m1) { m1 = e2; i1 = 2; } if (e3 > m1) { m1 = e3; i1 = 3; }
                int i2 = -1; float m2 = 0.f;
                if (i1 != 0) { m2 = e0; i2 = 0; }
                if (i1 != 1 && (i2 < 0 || e1 > m2)) { m2 = e1; i2 = 1; }
                if (i1 != 2 && (i2 < 0 || e2 > m2)) { m2 = e2; i2 = 2; }
                if (i1 != 3 && (i2 < 0 || e3 > m2)) { m2 = e3; i2 = 3; }
                const float p1 = 1.f / (1.f + expf(m2 - m1)), p2 = 1.f - p1;
                const int lo = i1 < i2 ? i1 : i2, hi = i1 < i2 ? i2 : i1;
                const int cls = 6 * g + (lo * (7 - lo)) / 2 + (hi - lo - 1);
                const float wlo = pg * (i1 == lo ? p1 : p2), whi = pg * (i1 == lo ? p2 : p1);
                rt_cls[m + rw] = cls; rt_w[2 * (m + rw)] = wlo; rt_w[2 * (m + rw) + 1] = whi;
                bcls[16 * wave + 2 * it + rw] = cls;
            }
            LDS_WAIT(); asm volatile("" ::: "memory");
        }
        __syncthreads();
        if (tid < 128) { const int c = bcls[tid]; int rank = 0; for (int t = 0; t < tid; ++t) rank += (bcls[t] == c) ? 1 : 0; rt_rank[128 * blk + tid] = rank; }
        else if (tid < 160) { const int c = tid - 128; int n = 0; for (int t = 0; t < 128; ++t) n += (bcls[t] == c) ? 1 : 0; bcnt[blk * 32 + c] = n; }
        __syncthreads();
    }
}
__device__ __forceinline__ void p7_lists(const Args& a, LAS unsigned char* lds, int vcu, int G) {
    const int tid = threadIdx.x; unsigned char* ws = a.ws;
    const int* bcnt = (const int*)(ws + RT_BCNT); const int* rt_cls = (const int*)(ws + RT_CLS); const int* rt_rank = (const int*)(ws + RT_RANK); const float* rt_w = (const float*)(ws + RT_W);
    int* list = (int*)(ws + RT_LIST); float* wsorted = (float*)(ws + RT_WS);
    LAS int* ptot = (LAS int*)lds; LAS int* pbef = (LAS int*)(lds + 4096); LAS int* bef = (LAS int*)(lds + 8192);
    LAS int* cls_off = (LAS int*)(lds + LC_OFF); LAS int* cls_tot = (LAS int*)(lds + LC_TOT); LAS int* tilecls = (LAS int*)(lds + LC_TCLS); LAS int* ntl = (LAS int*)(lds + LC_NT);
    for (int blk = vcu; blk < TR / 128; blk += G) {
        __syncthreads();
        if (tid < 384) { const int c = tid >> 4, seg = tid & 15; int tot = 0, bf = 0;
#pragma unroll
            for (int j = 0; j < 16; ++j) { const int b2 = 16 * seg + j; const int v = bcnt[b2 * 32 + c]; tot += v; bf += (b2 < blk) ? v : 0; }
            ptot[tid] = tot; pbef[tid] = bf; }
        __syncthreads();
        if (tid < 24) { int tot = 0, bf = 0; for (int s = 0; s < 16; ++s) { tot += ptot[tid * 16 + s]; bf += pbef[tid * 16 + s]; } cls_tot[tid] = tot; bef[tid] = bf; }
        __syncthreads();
        if (tid == 0) { int off = 0, nt = 0; for (int c = 0; c < 24; ++c) { cls_off[c] = off; const int n = (cls_tot[c] + 255) >> 8; for (int i = 0; i < n; ++i) tilecls[nt++] = c; off += n * 256; } cls_off[24] = off; ntl[0] = nt; }
        __syncthreads();
        if (tid < 128) { const int m = 128 * blk + tid; const int c = rt_cls[m]; const int pos = cls_off[c] + bef[c] + rt_rank[m]; list[pos] = m; wsorted[2 * pos] = rt_w[2 * m]; wsorted[2 * pos + 1] = rt_w[2 * m + 1]; }
        if (blk == 0) { for (int c = 0; c < 24; ++c) { const int p0 = cls_off[c] + cls_tot[c], p1 = cls_off[c + 1]; for (int p = p0 + tid; p < p1; p += 512) { list[p] = 0; wsorted[2 * p] = 0.f; wsorted[2 * p + 1] = 0.f; } } }
    }
    __syncthreads();
}
__device__ __forceinline__ void p10_final(const Args& a, int gw, int NGW, int lane) {
    const float* ssqp = (const float*)(a.ws + RT_SSQ); const float* fnw = a.in[18];
    f32x4 w[4];
#pragma unroll
    for (int j = 0; j < 4; ++j) w[j] = *((const f32x4*)fnw + lane + 64 * j);
    for (int m = gw; m < TR; m += NGW) {
        const f32x4* sp = (const f32x4*)(ssqp + (size_t)m * 16); const f32x4 a0 = sp[0], a1 = sp[1], a2 = sp[2], a3 = sp[3];
        const float ss = (((a0.x + a0.y) + (a0.z + a0.w)) + ((a1.x + a1.y) + (a1.z + a1.w))) + (((a2.x + a2.y) + (a2.z + a2.w)) + ((a3.x + a3.y) + (a3.z + a3.w)));
        const float rs = rsqrtf(ss * (1.f / D) + EPS);
        GAS f32x4* row = (GAS f32x4*)(a.out + (size_t)m * D) + lane;
#pragma unroll
        for (int j = 0; j < 4; ++j) { f32x4 v = row[64 * j]; v = v * rs * w[j]; row[64 * j] = v; }
    }
}

__device__ __forceinline__ void transpose_item(const float* W, int ldw, const float* kscale, bf16* WT, int ldt, int k0, int n0, int drow0, LAS float* scr, int lane) {
#pragma unroll 8
    for (int i = 0; i < 32; ++i) { const int kk = 2 * i + (lane >> 5); float v = W[(size_t)(k0 + kk) * ldw + n0 + (lane & 31)]; if (kscale) v *= kscale[k0 + kk]; scr[kk * 33 + (lane & 31)] = v; }
    LDS_WAIT(); asm volatile("" ::: "memory");
    const int c = lane & 7;
#pragma unroll
    for (int j = 0; j < 4; ++j) { const int n = (lane >> 3) + 8 * j; const LAS float* s = scr + (8 * c) * 33 + n;
        v4u o; o.x = pk2(s[0 * 33], s[1 * 33]); o.y = pk2(s[2 * 33], s[3 * 33]); o.z = pk2(s[4 * 33], s[5 * 33]); o.w = pk2(s[6 * 33], s[7 * 33]);
        *(GAS v4u*)(WT + (size_t)(drow0 + n) * ldt + k0 + 8 * c) = o; }
    LDS_WAIT(); asm volatile("" ::: "memory");
}

__device__ __forceinline__ void p0_prologue(const Args& a, LAS unsigned char* lds, int vcu, int G) {
    const int tid = threadIdx.x, lane = tid & 63, wave = __builtin_amdgcn_readfirstlane(tid >> 6);
    const float* x = a.in[0]; const float* meta = a.in[1]; const float* nmw = a.in[2]; const float* w_in = a.in[3];
    unsigned char* ws = a.ws;
#ifndef SKIP_C
    if (vcu < 33) {
        LAS float* mu_t = (LAS float*)lds;
        LAS float* red = (LAS float*)(lds + 65536);
        LAS float* mrs = (LAS float*)(lds + 65536 + 32768);
        for (int i = tid; i < 16 * 1024; i += 512) { const int r = i >> 10, k = i & 1023; mu_t[k * 16 + r] = meta[i] * nmw[k]; }
#pragma unroll
        for (int rr = 0; rr < 2; ++rr) { const int r = 2 * wave + rr; float s = 0.f;
            for (int j = 0; j < 16; ++j) { const float v = meta[r * 1024 + lane + 64 * j]; s += v * v; }
            s = wave_sum(s); if (lane == 0) mrs[r] = rsqrtf(s * (1.f / D) + EPS); }
        __syncthreads();
        const int n = vcu * 64 + lane, nn = n < INC ? n : INC - 1;
        float acc[16];
#pragma unroll
        for (int r = 0; r < 16; ++r) acc[r] = 0.f;
        const float* wp = w_in + (size_t)(128 * wave) * INC + nn;
#pragma unroll 4
        for (int k = 0; k < 128; ++k) { const float wv = wp[(size_t)k * INC]; const LAS f32x4* m4 = (const LAS f32x4*)(mu_t + (128 * wave + k) * 16);
#pragma unroll
            for (int q = 0; q < 4; ++q) { const f32x4 mm = m4[q]; acc[4 * q] += mm.x * wv; acc[4 * q + 1] += mm.y * wv; acc[4 * q + 2] += mm.z * wv; acc[4 * q + 3] += mm.w * wv; } }
#pragma unroll
        for (int r = 0; r < 16; ++r) red[(wave * 16 + r) * 64 + lane] = acc[r];
        __syncthreads();
#pragma unroll
        for (int rr = 0; rr < 2; ++rr) { const int r = 2 * wave + rr; float s = 0.f;
#pragma unroll
            for (int w = 0; w < 8; ++w) s += red[(w * 16 + r) * 64 + lane];
            if (n < INC) ((float*)(ws + WS_MPROJ))[r * INC + n] = s * mrs[r]; }
        __syncthreads();
    }
#endif
#ifndef SKIP_A
    {
        LAS float* scr = (LAS float*)(lds + wave * 16384);
        const int gw = vcu * NWAVES + wave, NGW = G * NWAVES;
        constexpr int I_IN = 16 * 64, I_OUT = 16 * 32, I_PW = 4 * 8, I_GU = NEXP * 256, I_D = NEXP * 128;
        for (int it0 = gw; it0 < I_IN + I_OUT + I_PW + I_GU + I_D; it0 += NGW) {
            int it = it0;
            if (it < I_IN) { transpose_item(w_in, INC, nmw, (bf16*)(ws + WS_WIN), D, 64 * (it / 64), 32 * (it % 64), 32 * (it % 64), scr, lane); continue; } it -= I_IN;
            if (it < I_OUT) { transpose_item(a.in[9], D, nullptr, (bf16*)(ws + WS_WOUT), D, 64 * (it / 32), 32 * (it % 32), 32 * (it % 32), scr, lane); continue; } it -= I_OUT;
            if (it < I_PW) { const int g = it / 8, r = it % 8; transpose_item(a.in[7] + g * 16384, 128, nullptr, (bf16*)(ws + WS_POOLW) + g * 16384, 128, 64 * (r / 4), 32 * (r % 4), 32 * (r % 4), scr, lane); continue; } it -= I_PW;
            if (it < I_GU) { const int e = it / 256, r = it % 256, isup = r / 128, r2 = r % 128, kb = r2 / 8, nb = r2 % 8;
                const float* src = (isup ? a.in[16] : a.in[15]) + (size_t)e * D * EH;
                transpose_item(src, EH, a.in[10], (bf16*)(ws + WS_WGU) + (size_t)e * 512 * D, D, 64 * kb, 32 * nb, 256 * (nb >> 2) + 128 * isup + ((32 * nb) & 127), scr, lane); continue; } it -= I_GU;
            { const int e = it / 128, r = it % 128; transpose_item(a.in[17] + (size_t)e * EH * D, D, nullptr, (bf16*)(ws + WS_WD) + (size_t)e * D * EH, EH, 64 * (r / 32), 32 * (r % 32), 32 * (r % 32), scr, lane); }
        }
    }
#endif
    __syncthreads();
#ifndef SKIP_B
    {
        LAS float* wg = (LAS float*)lds;
        for (int i = tid; i < 16 * 1024; i += 512) { const int k = i >> 4, q = i & 15; wg[q * 1024 + k] = nmw[k] * w_in[(size_t)k * INC + C_G + q]; }
        __syncthreads();
        const int gw = vcu * NWAVES + wave, NGW = G * NWAVES;
        float* rstd1 = (float*)(ws + WS_RSTD1); float* glr = (float*)(ws + WS_GLR); bf16* A0 = (bf16*)(ws + WS_A0);
        for (int p = gw; p < TR / 2; p += NGW) {
            const GAS f32x4* x0 = (const GAS f32x4*)(x + (size_t)(2 * p) * D) + lane; const GAS f32x4* x1 = x0 + D / 4;
            f32x4 v0[4], v1[4]; float s0 = 0.f, s1 = 0.f;
#pragma unroll
            for (int j = 0; j < 4; ++j) { v0[j] = x0[64 * j]; v1[j] = x1[64 * j]; }
#pragma unroll
            for (int j = 0; j < 4; ++j) { s0 += (v0[j].x * v0[j].x + v0[j].y * v0[j].y) + (v0[j].z * v0[j].z + v0[j].w * v0[j].w); s1 += (v1[j].x * v1[j].x + v1[j].y * v1[j].y) + (v1[j].z * v1[j].z + v1[j].w * v1[j].w); }
            s0 = wave_sum(s0); s1 = wave_sum(s1);
            const float r0 = rsqrtf(s0 * (1.f / D) + EPS), r1 = rsqrtf(s1 * (1.f / D) + EPS);
            GAS unsigned long long* o0 = (GAS unsigned long long*)(A0 + (size_t)(2 * p) * D) + lane; GAS unsigned long long* o1 = o0 + D / 4;
#pragma unroll
            for (int j = 0; j < 4; ++j) { o0[64 * j] = (unsigned long long)pk2(v0[j].x, v0[j].y) | ((unsigned long long)pk2(v0[j].z, v0[j].w) << 32);
                                          o1[64 * j] = (unsigned long long)pk2(v1[j].x, v1[j].y) | ((unsigned long long)pk2(v1[j].z, v1[j].w) << 32); }
            if (lane == 0) { rstd1[2 * p] = r0; rstd1[2 * p + 1] = r1; }
            float ac[32];
#pragma unroll
            for (int q = 0; q < 16; ++q) { float t0 = 0.f, t1 = 0.f;
#pragma unroll
                for (int j = 0; j < 4; ++j) { const f32x4 w4 = *(const LAS f32x4*)(wg + q * 1024 + 4 * lane + 256 * j);
                    t0 += (v0[j].x * w4.x + v0[j].y * w4.y) + (v0[j].z * w4.z + v0[j].w * w4.w); t1 += (v1[j].x * w4.x + v1[j].y * w4.y) + (v1[j].z * w4.z + v1[j].w * w4.w); }
                ac[q] = t0; ac[16 + q] = t1; if (q & 1) asm volatile("" ::: "memory"); }
            float b16[16], b8[8], b4[4], b2[2];
            { const bool hi = lane & 32;
#pragma unroll
              for (int i = 0; i < 16; ++i) { const float keep = hi ? ac[16 + i] : ac[i], send = hi ? ac[i] : ac[16 + i]; b16[i] = keep + __shfl_xor(send, 32); } }
            { const bool hi = lane & 16;
#pragma unroll
              for (int i = 0; i < 8; ++i) { const float keep = hi ? b16[8 + i] : b16[i], send = hi ? b16[i] : b16[8 + i]; b8[i] = keep + __shfl_xor(send, 16); } }
            { const bool hi = lane & 8;
#pragma unroll
              for (int i = 0; i < 4; ++i) { const float keep = hi ? b8[4 + i] : b8[i], send = hi ? b8[i] : b8[4 + i]; b4[i] = keep + __shfl_xor(send, 8); } }
            { const bool hi = lane & 4;
#pragma unroll
              for (int i = 0; i < 2; ++i) { const float keep = hi ? b4[2 + i] : b4[i], send = hi ? b4[i] : b4[2 + i]; b2[i] = keep + __shfl_xor(send, 4); } }
            float b1; { const bool hi = lane & 2; const float keep = hi ? b2[1] : b2[0], send = hi ? b2[0] : b2[1]; b1 = keep + __shfl_xor(send, 2); }
            b1 += __shfl_xor(b1, 1);
            if (!(lane & 1)) { const int rw = lane >> 5, q = (lane >> 1) & 15; glr[(size_t)(2 * p + rw) * 16 + q] = b1 * (rw ? r1 : r0); }
        }
    }
#endif
}

__global__ void __launch_bounds__(NWAVES * 64, 2) mega(Args args) {
    extern __shared__ __attribute__((aligned(16))) unsigned char lds_raw[];
    LAS unsigned char* lds = (LAS unsigned char*)lds_raw;
    const int tid = threadIdx.x;
    const int G = gridDim.x; int vcu; { const int bx = blockIdx.x; vcu = (G % 8 == 0) ? (bx % 8) * (G / 8) + bx / 8 : bx; }
    for (int u = tid; u < (LDS_BYTES - LDSCTL_OFF) / 4; u += NWAVES * 64) ((LAS unsigned*)(lds + LDSCTL_OFF))[u] = 0u;
    __syncthreads();
    XcdBarrier bar = xcd_barrier_post((unsigned*)(args.ws + WS_CTL) + CW_BAR, (volatile LAS unsigned*)(lds + MISC_OFF) + 8);
    const int lo = args.ph_lo, hi = args.ph_hi;
#define IN(k) (lo <= (k) && (k) < hi)
#define BOTH(k) (IN(k) && IN((k) + 1))
    unsigned char* ws = args.ws;
    if (IN(0)) { p0_prologue(args, lds, vcu, G); if (BOTH(0)) xcd_barrier(bar); }
    if (IN(1)) {
        pg8::DenseOrder S; S.init(TR, PC, G, (int)blockIdx.x); S.lda = D; S.ldb = D; S.Bt = (const char*)(ws + WS_WIN); S.bsplit = 1 << 30;
        pg8::EpiRowScaleBf16 E{(bf16*)(ws + WS_PROJ), PC, (const float*)(ws + WS_RSTD1)};
        pg8::gemm_phase2<pg8::EpiRowScaleBf16, pg8::DenseOrder, PG8_ALIGN>(lds + RING_OFF, (const char*)(ws + WS_A0), D, D, S, E);
        if (BOTH(1)) xcd_barrier(bar);
    }
    const int wave_ = __builtin_amdgcn_readfirstlane(tid >> 6), lane_ = tid & 63, gw_ = vcu * NWAVES + wave_, NGW_ = G * NWAVES;
    if (IN(2)) {
        if (gw_ < 32) gla_meta_unit(args, gw_, lane_);
        for (int u = gw_; u < 2048; u += NGW_) gla_pass1_unit(args, u, lane_);
        for (int u = gw_; u < 2048; u += NGW_) pool_unit(args, u, lane_, lds + wave_ * 16384);
        if (BOTH(2)) xcd_barrier(bar);
    }
    if (IN(3)) { gla_scan(args, (wave_ * G + vcu) * 64 + lane_, G * NWAVES * 64); if (BOTH(3)) xcd_barrier(bar); }
    if (IN(4)) { for (int u = gw_; u < 2048; u += NGW_) gla_pass2_unit(args, u, lane_); if (BOTH(4)) xcd_barrier(bar); }
    if (IN(5)) {
        pg8::DenseOrder S; S.init(TR, D, G, (int)blockIdx.x); S.lda = D; S.ldb = D; S.Bt = (const char*)(ws + WS_WOUT); S.bsplit = 1 << 30;
        pg8::EpiResF32 E{args.out, args.in[0], D};
        pg8::gemm_phase2<pg8::EpiResF32, pg8::DenseOrder, PG8_ALIGN>(lds + RING_OFF, (const char*)(ws + WS_YMIX), D, D, S, E);
        if (BOTH(5)) xcd_barrier(bar);
    }
    if (IN(6)) { p6_route(args, lds, vcu, G); if (BOTH(6)) xcd_barrier(bar); }
    if (IN(7)) { p7_lists(args, lds, vcu, G); if (BOTH(7)) xcd_barrier(bar); }
    if (IN(8) || IN(9)) {
        pg8::MoeTables T{(const LAS int*)(lds + LC_OFF), (const LAS int*)(lds + LC_TOT), (const LAS int*)(lds + LC_TCLS), *(const LAS int*)(lds + LC_NT)};
        if (IN(8)) {
            pg8::MoeUpOrder S{T, G, (int)blockIdx.x, (const int*)(ws + RT_LIST), (const char*)(ws + WS_WGU), 1 << 30};
            pg8::EpiSwiGLU E{(bf16*)(ws + WS_H), (const float*)(ws + RT_WS)};
            pg8::gemm_phase2<pg8::EpiSwiGLU, pg8::MoeUpOrder, PG8_ALIGN>(lds + RING_OFF, (const char*)(ws + WS_A0), D, D, S, E);
            if (BOTH(8)) xcd_barrier(bar);
        }
        if (IN(9)) {
            pg8::MoeDownOrder S{T, G, (int)blockIdx.x, (const char*)(ws + WS_WD), 4};
            pg8::EpiDownScatter E{args.out, (const int*)(ws + RT_LIST), (float*)(ws + RT_SSQ)};
            pg8::gemm_phase2<pg8::EpiDownScatter, pg8::MoeDownOrder, PG8_ALIGN>(lds + RING_OFF, (const char*)(ws + WS_H), 512, EH, S, E);
            if (BOTH(9)) xcd_barrier(bar);
        }
    }
    if (IN(10)) p10_final(args, gw_, NGW_, lane_);
#undef IN
#undef BOTH
}
#ifndef MEGA_PHASES
#define MEGA_PHASES 11
#endif
extern "C" void kernel_launch(void* const* d_in, const int* in_sizes, int n_in, void* d_out, int out_size, void* d_ws, size_t ws_size, hipStream_t stream) {
    static int grid = 0;
    if (grid == 0) {
        if (n_in != 19 || in_sizes[0] != TR * D || out_size != TR * D || ws_size < WS_END) { fprintf(stderr, "kernel_launch: unexpected shapes (n_in %d in0 %d out %d ws %zu); nothing launched\n", n_in, n_in > 0 ? in_sizes[0] : -1, out_size, ws_size); grid = -1; return; }
        int dev = 0, cus = 0, per_cu = 0;
        if (hipGetDevice(&dev) != hipSuccess || hipDeviceGetAttribute(&cus, hipDeviceAttributeMultiprocessorCount, dev) != hipSuccess) { grid = -1; return; }
        if (hipFuncSetAttribute((const void*)mega, hipFuncAttributeMaxDynamicSharedMemorySize, LDS_BYTES) != hipSuccess) { fprintf(stderr, "kernel_launch: hipFuncSetAttribute failed\n"); grid = -1; return; }
        if (hipOccupancyMaxActiveBlocksPerMultiprocessor(&per_cu, (const void*)mega, NWAVES * 64, LDS_BYTES) != hipSuccess || per_cu < 1) { fprintf(stderr, "kernel_launch: occupancy query says %d blocks/CU\n", per_cu); grid = -1; return; }
        grid = cus;
        fprintf(stderr, "kernel_launch: cus %d per_cu %d grid %d\n", cus, per_cu, grid);
    }
    if (grid < 0) return;
    if (hipMemsetAsync((char*)d_ws + WS_CTL, 0, CTL_ZERO_BYTES, stream) != hipSuccess) return;
    Args a{};
    for (int i = 0; i < 19; ++i) a.in[i] = (const float*)d_in[i];
    a.out = (float*)d_out; a.ws = (unsigned char*)d_ws; a.ph_lo = 0; a.ph_hi = MEGA_PHASES;
    void* kargs[] = {&a};
    hipError_t le = hipLaunchCooperativeKernel((const void*)mega, dim3(grid), dim3(NWAVES * 64), kargs, LDS_BYTES, stream);
    if (le != hipSuccess) { fprintf(stderr, "kernel_launch: cooperative launch failed: %s (grid %d)\n", hipGetErrorName(le), grid); return; }

}
```

```cpp
#include <hip/hip_runtime.h>
#include <cstdio>
#include <cstdint>

constexpr int D = 1024, BATCH = 4, SEQ = 8192, NMETA = 16;
constexpr int TR = BATCH * SEQ;
constexpr int R = NMETA + TR;
constexpr int INC = 2064;
constexpr int PC = 2048;
constexpr int C_POOL = 0, C_Q = 512, C_K = 768, C_V = 1024, C_R = 1536, C_G = 2048;
constexpr float EPS = 1e-6f;
constexpr int NEXP = 16, EH = 256;

constexpr size_t MiB = 1u << 20;
constexpr size_t WS_CTL = 0, CTL_ZERO_BYTES = 1 * MiB;
constexpr size_t WS_WIN = 2 * MiB;
constexpr size_t WS_WOUT = 6 * MiB;
constexpr size_t WS_POOLW = 8 * MiB;
constexpr size_t WS_WGU = 9 * MiB;
constexpr size_t WS_WD = 25 * MiB;
constexpr size_t WS_RSTD1 = 33 * MiB;
constexpr size_t WS_MPROJ = 33 * MiB + 256 * 1024;
constexpr size_t WS_GLR = 34 * MiB;
constexpr size_t WS_ROUTE = 37 * MiB;
constexpr size_t WS_A0 = 48 * MiB;
constexpr size_t WS_PROJ = 112 * MiB;
constexpr size_t WS_YMIX = 240 * MiB;
constexpr size_t WS_DS = 304 * MiB;
constexpr size_t WS_SS = 340 * MiB;
constexpr size_t WS_XS = 376 * MiB;
constexpr size_t WS_H = 456 * MiB;
constexpr size_t WS_END = 496 * MiB;
constexpr size_t WSN_YMIX = 240 * MiB;
constexpr size_t WSN_POOLED = 376 * MiB;
constexpr size_t WSN_DEC = 456 * MiB;

#define GAS __attribute__((address_space(1)))
#define LAS __attribute__((address_space(3)))
typedef unsigned short bf16;
typedef unsigned v4u __attribute__((ext_vector_type(4)));
typedef float f32x4 __attribute__((ext_vector_type(4)));
typedef GAS unsigned gu32;
#define RLX_AGENT __ATOMIC_RELAXED, __HIP_MEMORY_SCOPE_AGENT
#define LDS_WAIT() asm volatile("s_waitcnt lgkmcnt(0)" ::: "memory")
#define VM_WAIT() asm volatile("s_waitcnt vmcnt(0)" ::: "memory")
__device__ __forceinline__ unsigned f2bf(float f) { unsigned u = __builtin_bit_cast(unsigned, f); return (u + 0x7fffu + ((u >> 16) & 1u)) >> 16; }
__device__ __forceinline__ unsigned pk2(float lo, float hi) { return f2bf(lo) | (f2bf(hi) << 16); }
__device__ __forceinline__ float bf2f(bf16 b) { return __uint_as_float((unsigned)b << 16); }
__device__ __forceinline__ float wave_sum(float v) {
#pragma unroll
    for (int o = 1; o < 64; o <<= 1) v += __shfl_xor(v, o);
    return v;
}

constexpr int RING_OFF = 0, RING_BYTES = 131072;
constexpr int LDSCTL_OFF = RING_BYTES, MISC_OFF = LDSCTL_OFF + 320;
constexpr int LDS_BYTES = 147456;
constexpr int NWAVES = 8;
constexpr int CW_BAR = 4096;

struct Args { const float* in[19]; float* out; unsigned char* ws; int ph_lo, ph_hi; };

namespace pg8 {
#define PG8_LAS __attribute__((address_space(3)))
typedef unsigned short bf16_t;
typedef short bf16x8 __attribute__((ext_vector_type(8)));
typedef float f32x4 __attribute__((ext_vector_type(4)));
typedef unsigned u32x4 __attribute__((ext_vector_type(4)));
constexpr int BM = 256, BK = 64, HALF = 128, HTB = HALF * BK * 2  , STAGE_BYTES = 8 * HTB, NXCD = 8, WGM = 8;

__host__ __device__ __forceinline__ int lds_byte(int r, int c) { const int st = (r >> 4) * 2 + (c >> 5), rr = r & 15, cc = c & 31, ob = rr * 64 + cc * 2; return st * 1024 + (ob ^ (((ob >> 9) & 1) << 5)); }
__host__ __device__ __forceinline__ void stage_rc(int b, int& R, int& C) { const int st = b / 1024, sb = b % 1024, swz = sb ^ (((sb >> 9) & 1) << 5); R = (st >> 1) * 16 + swz / 64; C = (st & 1) * 32 + (swz % 64) / 2; }
__host__ __device__ __forceinline__ int perm32(int rho) { const int n = rho >> 4, i = rho & 15; return 8 * (i >> 2) + 4 * n + (i & 3); }

struct Unit { int pm, pn, cls, nrows; };
struct Gemm { const bf16_t* A; const bf16_t* Bt; int M, N, K; };

struct StaticOrder {
    int nM, nN, nwg, G, c;
    __host__ __device__ void init(int M, int N, int G_, int c_) { nM = M / BM; nN = N / BM; nwg = nM * nN; G = G_; c = c_; }
    __host__ __device__ bool next(int i, Unit& u) const {
        const long L = (long)i * G + c; if (L >= nwg) return false;
        int wgid = (int)L; { const int q = nwg / NXCD, r = nwg % NXCD, xcd = wgid % NXCD, off = wgid / NXCD; wgid = (xcd < r ? xcd * (q + 1) : r * (q + 1) + (xcd - r) * q) + off; }
        const int nig = WGM * nN, gid = wgid / nig, fm = gid * WGM, gsz = (nM - fm) < WGM ? (nM - fm) : WGM;
        u.pm = fm + ((wgid % nig) % gsz); u.pn = (wgid % nig) / gsz; return true;
    }
    __device__ __forceinline__ void a_ready(const Unit&) const {}
    __device__ __forceinline__ void done(const Unit&) const {}
};
__device__ __forceinline__ unsigned cvt_pk_bf16(float lo, float hi) { unsigned r; asm volatile("v_cvt_pk_bf16_f32 %0, %1, %2" : "=v"(r) : "v"(lo), "v"(hi)); return r; }
typedef float f32x2 __attribute__((ext_vector_type(2)));
template <class Epi, class Sched, bool ALIGN_EPI = false, bool SP2 = false>
__device__ __forceinline__ void gemm_phase(PG8_LAS unsigned char* lds, const Gemm g, const Sched& S, const Epi& E) {
    const int tid = threadIdx.x, wid = __builtin_amdgcn_readfirstlane(tid >> 6), lane = tid & 63, wr = wid >> 2, wc = wid & 3, fr = lane & 15, fq = lane >> 4;
    const int K = g.K, nt = K / BK;
    unsigned voffA[2], voffB[2];
#pragma unroll
    for (int i = 0; i < 2; ++i) { int R, C; stage_rc(tid * 16 + i * 8192, R, C); const int Rb = Epi::PERM ? ((R & ~31) + perm32(R & 31)) : R;
        voffA[i] = (unsigned)(R * K + C) * 2u; voffB[i] = (unsigned)(Rb * K + C) * 2u; }
    const size_t kstep = (size_t)(BK * 2);
    const size_t hstep = (size_t)HALF * K * 2;
    const size_t tstep = 2 * hstep;
    const unsigned ldsw = (unsigned)wid * 1024u;
    const int aoff = lds_byte(wr * 64 + fr, fq * 8), boff = lds_byte(wc * 32 + fr, fq * 8);
#define PG8_SA(b, h) (((b) * 2 + (h)) * HTB)
#define PG8_SB(b, h) ((4 + (b) * 2 + (h)) * HTB)
#define PG8_STAGE(bufoff, gbase, voff) do { _Pragma("unroll") for (int _i = 0; _i < 2; ++_i) \
        __builtin_amdgcn_global_load_lds((const unsigned*)((const char*)(gbase) + (voff)[_i]), (PG8_LAS unsigned*)(lds + (bufoff) + ldsw + _i * 8192), 16, 0, 0); } while (0)
#define PG8_LDA(dst, b, h) do { _Pragma("unroll") for (int m = 0; m < 4; ++m) _Pragma("unroll") for (int k = 0; k < 2; ++k) dst[m][k] = *(const PG8_LAS bf16x8*)(lds + PG8_SA(b, h) + aoff + m * 2048 + k * 1024); } while (0)
#define PG8_LDB(dst, b, h) do { _Pragma("unroll") for (int n = 0; n < 2; ++n) _Pragma("unroll") for (int k = 0; k < 2; ++k) dst[n][k] = *(const PG8_LAS bf16x8*)(lds + PG8_SB(b, h) + boff + n * 2048 + k * 1024); } while (0)
#define PG8_MMA(ai, bj, At, Bt) do { __builtin_amdgcn_s_setprio(1); _Pragma("unroll") for (int m = 0; m < 4; ++m) _Pragma("unroll") for (int n = 0; n < 2; ++n) _Pragma("unroll") for (int k = 0; k < 2; ++k) \
        acc[ai][bj][m][n] = __builtin_amdgcn_mfma_f32_16x16x32_bf16(Bt[n][k], At[m][k], acc[ai][bj][m][n], 0, 0, 0); __builtin_amdgcn_s_setprio(0); } while (0)
#define PG8_WAIT_V(n) asm volatile("s_waitcnt vmcnt(" #n ")" ::: "memory")
#define PG8_WAIT_L(n) asm volatile("s_waitcnt lgkmcnt(" #n ")" ::: "memory")
#define PG8_BAR __builtin_amdgcn_s_barrier()
#define PG8_SCHED __builtin_amdgcn_sched_barrier(0)
    Unit cur, nxt; int ui = 0;
    if (!S.next(0, cur)) return;
    f32x4 acc[2][2][4][2];
#pragma unroll
    for (int a = 0; a < 2; ++a)
#pragma unroll
        for (int b = 0; b < 2; ++b)
#pragma unroll
            for (int m = 0; m < 4; ++m)
#pragma unroll
                for (int n = 0; n < 2; ++n) acc[a][b][m][n] = (f32x4){0.f, 0.f, 0.f, 0.f};
    bf16x8 At[4][2], B0[2][2], B1[2][2];
    const char* cA = (const char*)g.A + (size_t)cur.pm * tstep; const char* cB = (const char*)g.Bt + (size_t)cur.pn * tstep;
    S.a_ready(cur);
    if constexpr (SP2) {
        PG8_STAGE(PG8_SB(0, 0), cB, voffB); PG8_STAGE(PG8_SB(0, 1), cB + hstep, voffB); PG8_STAGE(PG8_SA(0, 0), cA, voffA); PG8_STAGE(PG8_SA(0, 1), cA + hstep, voffA);
        if (wr == 1) PG8_BAR;
        PG8_WAIT_V(2); PG8_BAR;
        PG8_STAGE(PG8_SB(1, 0), cB + kstep, voffB); PG8_STAGE(PG8_SA(1, 0), cA + kstep, voffA); PG8_STAGE(PG8_SB(1, 1), cB + hstep + kstep, voffB);
        PG8_WAIT_V(6); PG8_BAR;
    } else {
        PG8_STAGE(PG8_SB(0, 0), cB, voffB); PG8_STAGE(PG8_SA(0, 0), cA, voffA); PG8_STAGE(PG8_SB(0, 1), cB + hstep, voffB); PG8_STAGE(PG8_SA(0, 1), cA + hstep, voffA);
        if (wr == 1) PG8_BAR;
        PG8_WAIT_V(4); PG8_BAR;
        PG8_STAGE(PG8_SB(1, 0), cB + kstep, voffB); PG8_STAGE(PG8_SA(1, 0), cA + kstep, voffA); PG8_STAGE(PG8_SB(1, 1), cB + hstep + kstep, voffB);
        PG8_WAIT_V(6); PG8_BAR;
    }
    for (;;) {
        const bool has_next = S.next(ui + 1, nxt);
        const char* nA = has_next ? (const char*)g.A + (size_t)nxt.pm * tstep : cA; const char* nB = has_next ? (const char*)g.Bt + (size_t)nxt.pn * tstep : cB;
        for (int t = 0; t < nt; t += 2) {
            const bool last = (t == nt - 2);
            const char* a1 = cA + (size_t)(t + 1) * kstep;
            const char* a2 = last ? nA : cA + (size_t)(t + 2) * kstep; const char* b2 = last ? nB : cB + (size_t)(t + 2) * kstep;
            const char* a3 = a2 + kstep; const char* b3 = b2 + kstep;
            if (last && has_next) S.a_ready(nxt);
            if constexpr (SP2) {
            PG8_LDB(B0, 0, 0); PG8_LDB(B1, 0, 1); PG8_SCHED; PG8_LDA(At, 0, 0); PG8_STAGE(PG8_SA(1, 1), a1 + hstep, voffA);
            PG8_WAIT_V(8); PG8_WAIT_L(0); PG8_BAR; PG8_MMA(0, 0, At, B0); PG8_MMA(0, 1, At, B1); PG8_BAR; PG8_SCHED;
            PG8_LDA(At, 0, 1); PG8_STAGE(PG8_SB(0, 0), b2, voffB); PG8_STAGE(PG8_SB(0, 1), b2 + hstep, voffB); PG8_STAGE(PG8_SA(0, 0), a2, voffA);
            PG8_WAIT_V(8); PG8_WAIT_L(0); PG8_BAR; PG8_MMA(1, 0, At, B0); PG8_MMA(1, 1, At, B1); PG8_BAR; PG8_SCHED;
            PG8_LDB(B0, 1, 0); PG8_LDB(B1, 1, 1); PG8_SCHED; PG8_LDA(At, 1, 0); PG8_STAGE(PG8_SA(0, 1), a2 + hstep, voffA);
            PG8_WAIT_V(8); PG8_WAIT_L(0); PG8_BAR; PG8_MMA(0, 0, At, B0); PG8_MMA(0, 1, At, B1); PG8_BAR; PG8_SCHED;
            PG8_LDA(At, 1, 1); PG8_STAGE(PG8_SB(1, 0), b3, voffB); PG8_STAGE(PG8_SB(1, 1), b3 + hstep, voffB); PG8_STAGE(PG8_SA(1, 0), a3, voffA);
            PG8_WAIT_V(8); PG8_WAIT_L(0); PG8_BAR; PG8_MMA(1, 0, At, B0); PG8_MMA(1, 1, At, B1); PG8_BAR; PG8_SCHED;
            } else {
            PG8_LDB(B0, 0, 0); PG8_SCHED; PG8_LDA(At, 0, 0); PG8_STAGE(PG8_SA(1, 1), a1 + hstep, voffA);
            PG8_WAIT_L(8); PG8_BAR; PG8_WAIT_L(0); PG8_MMA(0, 0, At, B0); PG8_BAR; PG8_SCHED;
            PG8_LDB(B1, 0, 1); PG8_STAGE(PG8_SB(0, 0), b2, voffB);
            PG8_BAR; PG8_WAIT_L(0); PG8_MMA(0, 1, At, B1); PG8_BAR;
            PG8_LDA(At, 0, 1); PG8_STAGE(PG8_SA(0, 0), a2, voffA);
            PG8_BAR; PG8_WAIT_L(0); PG8_MMA(1, 0, At, B0); PG8_BAR; PG8_SCHED;
            PG8_STAGE(PG8_SB(0, 1), b2 + hstep, voffB);
            PG8_WAIT_V(6); PG8_BAR; PG8_MMA(1, 1, At, B1); PG8_BAR;
            PG8_LDB(B0, 1, 0); PG8_SCHED; PG8_LDA(At, 1, 0); PG8_STAGE(PG8_SA(0, 1), a2 + hstep, voffA);
            PG8_WAIT_L(8); PG8_BAR; PG8_WAIT_L(0); PG8_MMA(0, 0, At, B0); PG8_BAR; PG8_SCHED;
            PG8_LDB(B1, 1, 1); PG8_STAGE(PG8_SB(1, 0), b3, voffB);
            PG8_BAR; PG8_WAIT_L(0); PG8_MMA(0, 1, At, B1); PG8_BAR;
            PG8_LDA(At, 1, 1); PG8_STAGE(PG8_SA(1, 0), a3, voffA);
            PG8_BAR; PG8_WAIT_L(0); PG8_MMA(1, 0, At, B0); PG8_BAR; PG8_SCHED;
            PG8_STAGE(PG8_SB(1, 1), b3 + hstep, voffB);
            PG8_WAIT_V(6); PG8_BAR; PG8_MMA(1, 1, At, B1); PG8_BAR;
            }
        }
        if constexpr (ALIGN_EPI) { if (wr == 0) PG8_BAR; }
        if constexpr (!Epi::AFTER_DRAIN) { E(acc, cur, wr, wc, fr, fq); S.done(cur); }
        if (!has_next) break;
#pragma unroll
        for (int a = 0; a < 2; ++a)
#pragma unroll
            for (int b = 0; b < 2; ++b)
#pragma unroll
                for (int m = 0; m < 4; ++m)
#pragma unroll
                    for (int n = 0; n < 2; ++n) acc[a][b][m][n] = (f32x4){0.f, 0.f, 0.f, 0.f};
        cur = nxt; cA = nA; cB = nB; ++ui;
        if constexpr (ALIGN_EPI) { if (wr == 1) PG8_BAR; }
    }
    PG8_WAIT_V(0);
    if constexpr (!ALIGN_EPI) { if (wr == 0) PG8_BAR; }
    PG8_BAR;
    if constexpr (Epi::AFTER_DRAIN) { E.fused(acc, cur, wr, wc, fr, fq, lds, wid, lane); S.done(cur); }
#undef PG8_SA
#undef PG8_SB
#undef PG8_STAGE
#undef PG8_LDA
#undef PG8_LDB
#undef PG8_MMA
#undef PG8_WAIT_V
#undef PG8_WAIT_L
#undef PG8_BAR
#undef PG8_SCHED
}
template <class Epi, class Sched, bool ALIGN_EPI>
__device__ __forceinline__ void gemm_phase2(PG8_LAS unsigned char* lds, const char* Abase, const int K, const int ldb, const Sched& S, const Epi& E) {
    const int tid = threadIdx.x, wid = __builtin_amdgcn_readfirstlane(tid >> 6), lane = tid & 63, wr = wid >> 2, wc = wid & 3, fr = lane & 15, fq = lane >> 4;
    const int nt = K / BK;
    int RA[2], CA[2]; unsigned voffB[2];
#pragma unroll
    for (int i = 0; i < 2; ++i) { int R, C; stage_rc(tid * 16 + i * 8192, R, C); const int Rb = Epi::PERM ? ((R & ~31) + perm32(R & 31)) : R;
        RA[i] = R; CA[i] = C * 2; voffB[i] = (unsigned)(Rb * ldb + C) * 2u; }
    const size_t kstep = (size_t)(BK * 2);
    const size_t hstepB = (size_t)HALF * ldb * 2;
    const unsigned ldsw = (unsigned)wid * 1024u;
    const int aoff = lds_byte(wr * 64 + fr, fq * 8), boff = lds_byte(wc * 32 + fr, fq * 8);
    const int bsplit = S.bsplit;
#define PG8_SA(b, h) (((b) * 2 + (h)) * HTB)
#define PG8_SB(b, h) ((4 + (b) * 2 + (h)) * HTB)
#define PG8_STAGE(bufoff, gbase, voff) do { _Pragma("unroll") for (int _i = 0; _i < 2; ++_i) \
        __builtin_amdgcn_global_load_lds((const unsigned*)((const char*)(gbase) + (voff)[_i]), (PG8_LAS unsigned*)(lds + (bufoff) + ldsw + _i * 8192), 16, 0, 0); } while (0)
#define PG8_BT(base, delta, tt) ((base) + (size_t)(tt) * kstep + ((tt) >= bsplit ? (delta) : (long)0))
#define PG8_LDA(dst, b, h) do { _Pragma("unroll") for (int m = 0; m < 4; ++m) _Pragma("unroll") for (int k = 0; k < 2; ++k) dst[m][k] = *(const PG8_LAS bf16x8*)(lds + PG8_SA(b, h) + aoff + m * 2048 + k * 1024); } while (0)
#define PG8_LDB(dst, b, h) do { _Pragma("unroll") for (int n = 0; n < 2; ++n) _Pragma("unroll") for (int k = 0; k < 2; ++k) dst[n][k] = *(const PG8_LAS bf16x8*)(lds + PG8_SB(b, h) + boff + n * 2048 + k * 1024); } while (0)
#define PG8_MMA(ai, bj, At, Bt) do { __builtin_amdgcn_s_setprio(1); _Pragma("unroll") for (int m = 0; m < 4; ++m) _Pragma("unroll") for (int n = 0; n < 2; ++n) _Pragma("unroll") for (int k = 0; k < 2; ++k) \
        acc[ai][bj][m][n] = __builtin_amdgcn_mfma_f32_16x16x32_bf16(Bt[n][k], At[m][k], acc[ai][bj][m][n], 0, 0, 0); __builtin_amdgcn_s_setprio(0); } while (0)
#define PG8_WAIT_V(n) asm volatile("s_waitcnt vmcnt(" #n ")" ::: "memory")
#define PG8_WAIT_L(n) asm volatile("s_waitcnt lgkmcnt(" #n ")" ::: "memory")
#define PG8_BAR __builtin_amdgcn_s_barrier()
#define PG8_SCHED __builtin_amdgcn_sched_barrier(0)
    Unit cur, nxt; int ui = 0;
    if (!S.next(0, cur)) return;
    f32x4 acc[2][2][4][2];
#pragma unroll
    for (int a = 0; a < 2; ++a)
#pragma unroll
        for (int b = 0; b < 2; ++b)
#pragma unroll
            for (int m = 0; m < 4; ++m)
#pragma unroll
                for (int n = 0; n < 2; ++n) acc[a][b][m][n] = (f32x4){0.f, 0.f, 0.f, 0.f};
    bf16x8 At[4][2], B0[2][2], B1[2][2];
    unsigned oc[2][2], on[2][2];
    S.a_offs(cur, RA, CA, oc);
    const char* cB = S.b_base(cur); long cD = S.b_delta(cur);
    PG8_STAGE(PG8_SB(0, 0), PG8_BT(cB, cD, 0), voffB); PG8_STAGE(PG8_SB(0, 1), PG8_BT(cB, cD, 0) + hstepB, voffB); PG8_STAGE(PG8_SA(0, 0), Abase, oc[0]); PG8_STAGE(PG8_SA(0, 1), Abase, oc[1]);
    if (wr == 1) PG8_BAR;
    PG8_WAIT_V(2); PG8_BAR;
    PG8_STAGE(PG8_SB(1, 0), PG8_BT(cB, cD, 1), voffB); PG8_STAGE(PG8_SA(1, 0), Abase + kstep, oc[0]); PG8_STAGE(PG8_SB(1, 1), PG8_BT(cB, cD, 1) + hstepB, voffB);
    PG8_WAIT_V(6); PG8_BAR;
    for (;;) {
        const bool has_next = S.next(ui + 1, nxt);
        if (!has_next) nxt = cur;
        S.a_offs(nxt, RA, CA, on);
        const char* nB = S.b_base(nxt); const long nD = S.b_delta(nxt);
        for (int t = 0; t < nt; t += 2) {
            const bool last = (t == nt - 2);
            const char* a1 = Abase + (size_t)(t + 1) * kstep;
            const char* a2 = last ? Abase : Abase + (size_t)(t + 2) * kstep; const char* a3 = a2 + kstep;
            const char* b2 = last ? PG8_BT(nB, nD, 0) : PG8_BT(cB, cD, t + 2); const char* b3 = last ? PG8_BT(nB, nD, 1) : PG8_BT(cB, cD, t + 3);
            unsigned o2[2][2];
#pragma unroll
            for (int h = 0; h < 2; ++h)
#pragma unroll
                for (int i = 0; i < 2; ++i) o2[h][i] = last ? on[h][i] : oc[h][i];
            PG8_LDB(B0, 0, 0); PG8_LDB(B1, 0, 1); PG8_SCHED; PG8_LDA(At, 0, 0); PG8_STAGE(PG8_SA(1, 1), a1, oc[1]);
            PG8_WAIT_V(8); PG8_WAIT_L(0); PG8_BAR; PG8_MMA(0, 0, At, B0); PG8_MMA(0, 1, At, B1); PG8_BAR; PG8_SCHED;
            PG8_LDA(At, 0, 1); PG8_STAGE(PG8_SB(0, 0), b2, voffB); PG8_STAGE(PG8_SB(0, 1), b2 + hstepB, voffB); PG8_STAGE(PG8_SA(0, 0), a2, o2[0]);
            PG8_WAIT_V(8); PG8_WAIT_L(0); PG8_BAR; PG8_MMA(1, 0, At, B0); PG8_MMA(1, 1, At, B1); PG8_BAR; PG8_SCHED;
            PG8_LDB(B0, 1, 0); PG8_LDB(B1, 1, 1); PG8_SCHED; PG8_LDA(At, 1, 0); PG8_STAGE(PG8_SA(0, 1), a2, o2[1]);
            PG8_WAIT_V(8); PG8_WAIT_L(0); PG8_BAR; PG8_MMA(0, 0, At, B0); PG8_MMA(0, 1, At, B1); PG8_BAR; PG8_SCHED;
            PG8_LDA(At, 1, 1); PG8_STAGE(PG8_SB(1, 0), b3, voffB); PG8_STAGE(PG8_SB(1, 1), b3 + hstepB, voffB); PG8_STAGE(PG8_SA(1, 0), a3, o2[0]);
            PG8_WAIT_V(8); PG8_WAIT_L(0); PG8_BAR; PG8_MMA(1, 0, At, B0); PG8_MMA(1, 1, At, B1); PG8_BAR; PG8_SCHED;
        }
        if constexpr (ALIGN_EPI) { if (wr == 0) PG8_BAR; }
        E(acc, cur, wr, wc, fr, fq);
        if (!has_next) break;
#pragma unroll
        for (int a = 0; a < 2; ++a)
#pragma unroll
            for (int b = 0; b < 2; ++b)
#pragma unroll
                for (int m = 0; m < 4; ++m)
#pragma unroll
                    for (int n = 0; n < 2; ++n) acc[a][b][m][n] = (f32x4){0.f, 0.f, 0.f, 0.f};
        cur = nxt; cB = nB; cD = nD; ++ui;
#pragma unroll
        for (int h = 0; h < 2; ++h)
#pragma unroll
            for (int i = 0; i < 2; ++i) oc[h][i] = on[h][i];
        if constexpr (ALIGN_EPI) { if (wr == 1) PG8_BAR; }
    }
    PG8_WAIT_V(0);
    if constexpr (!ALIGN_EPI) { if (wr == 0) PG8_BAR; }
    PG8_BAR;
#undef PG8_SA
#undef PG8_SB
#undef PG8_STAGE
#undef PG8_BT
#undef PG8_LDA
#undef PG8_LDB
#undef PG8_MMA
#undef PG8_WAIT_V
#undef PG8_WAIT_L
#undef PG8_BAR
#undef PG8_SCHED
}
struct DenseOrder : StaticOrder {
    int lda, ldb; const char* Bt; int bsplit;
    __device__ __forceinline__ void a_offs(const Unit& u, const int (&RA)[2], const int (&CA)[2], unsigned (&o)[2][2]) const {
#pragma unroll
        for (int h = 0; h < 2; ++h)
#pragma unroll
            for (int i = 0; i < 2; ++i) o[h][i] = (unsigned)((u.pm * BM + h * HALF + RA[i]) * lda) * 2u + (unsigned)CA[i]; }
    __device__ __forceinline__ const char* b_base(const Unit& u) const { return Bt + (size_t)u.pn * BM * ldb * 2; }
    __device__ __forceinline__ long b_delta(const Unit&) const { return 0; }
};
struct EpiResF32 {
    static constexpr bool PERM = false, AFTER_DRAIN = false;
    float* C; const float* res; int ldc;
    __device__ __forceinline__ void operator()(const f32x4 (&acc)[2][2][4][2], const Unit& u, int wr, int wc, int fr, int fq) const {
        const int row0 = u.pm * BM + wr * 64 + fr, col0 = u.pn * BM + wc * 32 + 4 * fq;
#pragma unroll
        for (int ai = 0; ai < 2; ++ai)
#pragma unroll
            for (int m = 0; m < 4; ++m) { const size_t off = (size_t)(row0 + ai * HALF + m * 16) * ldc + col0;
#pragma unroll
                for (int bj = 0; bj < 2; ++bj)
#pragma unroll
                    for (int n = 0; n < 2; ++n) { const f32x4 r = *(const f32x4*)(res + off + bj * HALF + n * 16); *(f32x4*)(C + off + bj * HALF + n * 16) = acc[ai][bj][m][n] + r; }
                if (m & 1) asm volatile("" ::: "memory"); }
    }
};
__device__ __forceinline__ void cls_experts(int cls, int& elo, int& ehi) { const int g = cls / 6, p = cls - 6 * g; const int lo = p < 3 ? 0 : (p < 5 ? 1 : 2), hi = p < 3 ? p + 1 : (p < 5 ? p - 1 : 3); elo = 4 * g + lo; ehi = 4 * g + hi; }
struct MoeTables { const PG8_LAS int* cls_off; const PG8_LAS int* cls_tot; const PG8_LAS int* tilecls; int ntiles; };
struct MoeUpOrder {
    MoeTables T; int G, c; const int* list; const char* Wgu; int bsplit;
    __device__ __forceinline__ bool next(int i, Unit& u) const { const int L = i * G + c; const int mt = L >> 2; if (mt >= T.ntiles) return false; u.pm = mt; u.pn = L & 3; u.cls = T.tilecls[mt]; u.nrows = 0; return true; }
    __device__ __forceinline__ void a_offs(const Unit& u, const int (&RA)[2], const int (&CA)[2], unsigned (&o)[2][2]) const {
#pragma unroll
        for (int h = 0; h < 2; ++h)
#pragma unroll
            for (int i = 0; i < 2; ++i) o[h][i] = (unsigned)list[u.pm * BM + h * HALF + RA[i]] * 2048u + (unsigned)CA[i]; }
    __device__ __forceinline__ const char* b_base(const Unit& u) const { int elo, ehi; cls_experts(u.cls, elo, ehi); const int e = (u.pn >> 1) ? ehi : elo; return Wgu + ((size_t)e * 512 + 256 * (u.pn & 1)) * 2048; }
    __device__ __forceinline__ long b_delta(const Unit&) const { return 0; }
};
struct MoeDownOrder {
    MoeTables T; int G, c; const char* Wd; int bsplit;
    __device__ __forceinline__ bool next(int i, Unit& u) const { const int L = i * G + c; const int mt = L >> 2; if (mt >= T.ntiles) return false; u.pm = mt; u.pn = L & 3; u.cls = T.tilecls[mt];
        const int rem = T.cls_off[u.cls] + T.cls_tot[u.cls] - mt * BM; u.nrows = rem < BM ? rem : BM; return true; }
    __device__ __forceinline__ void a_offs(const Unit& u, const int (&RA)[2], const int (&CA)[2], unsigned (&o)[2][2]) const {
#pragma unroll
        for (int h = 0; h < 2; ++h)
#pragma unroll
            for (int i = 0; i < 2; ++i) o[h][i] = (unsigned)(u.pm * BM + h * HALF + RA[i]) * 1024u + (unsigned)CA[i]; }
    __device__ __forceinline__ const char* b_base(const Unit& u) const { int elo, ehi; cls_experts(u.cls, elo, ehi); return Wd + ((size_t)elo * 1024 + 256 * u.pn) * 512; }
    __device__ __forceinline__ long b_delta(const Unit& u) const { int elo, ehi; cls_experts(u.cls, elo, ehi); return (long)(ehi - elo) * 1024 * 512 - 4 * 128; }
};
struct EpiSwiGLU {
    static constexpr bool PERM = true, AFTER_DRAIN = false;
    bf16_t* H; const float* wsorted;
    __device__ __forceinline__ void operator()(const f32x4 (&acc)[2][2][4][2], const Unit& u, int wr, int wc, int fr, int fq) const {
        const int row0 = u.pm * BM + wr * 64 + fr, q = u.pn >> 1, col0 = 256 * q + 128 * (u.pn & 1) + wc * 32 + 8 * fq;
#pragma unroll
        for (int ai = 0; ai < 2; ++ai)
#pragma unroll
            for (int m = 0; m < 4; ++m) { const int row = row0 + ai * HALF + m * 16; const float w = wsorted[2 * row + q];
                float o[8];
#pragma unroll
                for (int n = 0; n < 2; ++n)
#pragma unroll
                    for (int j = 0; j < 4; ++j) { const float g = acc[ai][0][m][n][j], up = acc[ai][1][m][n][j]; o[4 * n + j] = w * up * g * __builtin_amdgcn_rcpf(1.f + __expf(-g)); }
                u32x4 pk; pk.x = cvt_pk_bf16(o[0], o[1]); pk.y = cvt_pk_bf16(o[2], o[3]); pk.z = cvt_pk_bf16(o[4], o[5]); pk.w = cvt_pk_bf16(o[6], o[7]);
                *(u32x4*)(H + (size_t)row * 512 + col0) = pk; }
    }
};
struct EpiDownScatter {
    static constexpr bool PERM = false, AFTER_DRAIN = false;
    float* out; const int* list; float* ssqp;
    __device__ __forceinline__ void operator()(const f32x4 (&acc)[2][2][4][2], const Unit& u, int wr, int wc, int fr, int fq) const {
        const int col0 = u.pn * BM + wc * 32 + 4 * fq;
#pragma unroll
        for (int ai = 0; ai < 2; ++ai)
#pragma unroll
            for (int m = 0; m < 4; ++m) { const int rl = ai * HALF + wr * 64 + m * 16 + fr; const bool ok = rl < u.nrows; const int tok = list[u.pm * BM + rl];
                float* rowp = out + (size_t)tok * 1024 + col0; float ss = 0.f;
#pragma unroll
                for (int bj = 0; bj < 2; ++bj)
#pragma unroll
                    for (int n = 0; n < 2; ++n) { const f32x4 r = *(const f32x4*)(rowp + bj * HALF + n * 16); const f32x4 v = acc[ai][bj][m][n] + r;
                        ss += (v[0] * v[0] + v[1] * v[1]) + (v[2] * v[2] + v[3] * v[3]); if (ok) *(f32x4*)(rowp + bj * HALF + n * 16) = v; }
                ss += __shfl_xor(ss, 16); ss += __shfl_xor(ss, 32);
                if (ok && fq == 0) ssqp[(size_t)tok * 16 + 4 * u.pn + wc] = ss;
                if (m & 1) asm volatile("" ::: "memory"); }
    }
};
struct EpiRowScaleBf16 {
    static constexpr bool PERM = true, AFTER_DRAIN = false;
    bf16_t* O; int ldc; const float* rs;
    __device__ __forceinline__ void operator()(const f32x4 (&acc)[2][2][4][2], const Unit& u, int wr, int wc, int fr, int fq) const {
        const int row0 = u.pm * BM + wr * 64 + fr, col0 = u.pn * BM + wc * 32 + 8 * fq;
#pragma unroll
        for (int ai = 0; ai < 2; ++ai)
#pragma unroll
            for (int m = 0; m < 4; ++m) { const int row = row0 + ai * HALF + m * 16; const float s = rs[row]; bf16_t* rowp = O + (size_t)row * ldc + col0;
#pragma unroll
                for (int bj = 0; bj < 2; ++bj) { const f32x4 v0 = acc[ai][bj][m][0] * s, v1 = acc[ai][bj][m][1] * s;
                    u32x4 w; w.x = cvt_pk_bf16(v0[0], v0[1]); w.y = cvt_pk_bf16(v0[2], v0[3]); w.z = cvt_pk_bf16(v1[0], v1[1]); w.w = cvt_pk_bf16(v1[2], v1[3]);
                    *(u32x4*)(rowp + bj * HALF) = w; } }
    }
};
}
#define PG8_SP2 true
#define PG8_ALIGN true
#define XB_TMO      128
#define XB_XCNT(j)  (256  + 64 * (j))
#define XB_XSUB(j)  (1280 + 64 * (j))
#define XB_XGEN(j)  (2304 + 64 * (j))
#define XB_TOP      3328
#define XB_TOPGEN   3392
#define XCD_BAR_WORDS 3456
#define XB_SPIN_CAP (1u << 18)

__device__ __forceinline__ unsigned xb_ld(unsigned* p)              { return __hip_atomic_load(p, __ATOMIC_RELAXED, __HIP_MEMORY_SCOPE_AGENT); }
__device__ __forceinline__ unsigned xb_add(unsigned* p, unsigned v) { return __hip_atomic_fetch_add(p, v, __ATOMIC_RELAXED, __HIP_MEMORY_SCOPE_AGENT); }
__device__ __forceinline__ unsigned xb_xcc_id() { return (unsigned)__builtin_amdgcn_s_getreg((3 << 11) | 20) & 0xFu; }
#define XB_SPIN(cond, bar) do { unsigned _sp = 0; while (cond) { __builtin_amdgcn_s_sleep(1); \
    if ((++_sp & 255u) == 0u) { if (xb_ld(&(bar)[XB_TMO])) break; if (_sp > XB_SPIN_CAP) { atomicAdd(&(bar)[XB_TMO], 1u); break; } } } } while (0)

struct XcdBarrier {
    unsigned* bar; unsigned x;
    volatile LAS unsigned* st;
};

__device__ __forceinline__ XcdBarrier xcd_barrier_post(unsigned* bar, volatile LAS unsigned* st) {
    XcdBarrier b; b.bar = bar; b.x = xb_xcc_id(); b.st = st;
    if (threadIdx.x == 0) (void)xb_add(&bar[XB_XCNT(b.x)], 1u);
    return b;
}
__device__ __forceinline__ void xcd_barrier_complete(unsigned* bar, unsigned x, unsigned& nloc, unsigned& nx) {
    const unsigned G = gridDim.x * gridDim.y * gridDim.z;
    unsigned sum, cnt, mine, sp = 0u;
    for (;;) {
        sum = 0u; cnt = 0u; mine = 0u;
#pragma unroll
        for (unsigned j = 0; j < 16; ++j) { const unsigned c = xb_ld(&bar[XB_XCNT(j)]); sum += c; cnt += (c > 0u) ? 1u : 0u; mine = (j == x) ? c : mine; }
        if (sum == G) break;
        __builtin_amdgcn_s_sleep(1);
        if ((++sp & 255u) == 0u) { if (xb_ld(&bar[XB_TMO])) break; if (sp > XB_SPIN_CAP) { atomicAdd(&bar[XB_TMO], 1u); break; } }
    }
    nloc = mine > 0u ? mine : 1u; nx = cnt > 0u ? cnt : 1u;
}

__device__ __forceinline__ void xcd_barrier(const XcdBarrier& b) {
    asm volatile("s_waitcnt vmcnt(0)" ::: "memory");
    __syncthreads();
    if (threadIdx.x == 0) {
        unsigned* bar = b.bar;
        __builtin_amdgcn_s_waitcnt(0);
        unsigned nloc = b.st[0], nx = b.st[1];
        if (nloc == 0u) { xcd_barrier_complete(bar, b.x, nloc, nx); b.st[0] = nloc; b.st[1] = nx; }
        const unsigned old = xb_add(&bar[XB_XSUB(b.x)], 1u);
        const unsigned gen = old / nloc;
        if (old + 1u == (gen + 1u) * nloc) {
            __builtin_amdgcn_fence(__ATOMIC_RELEASE, "agent");
            asm volatile("s_waitcnt vmcnt(0)" ::: "memory");
            const unsigned og = xb_add(&bar[XB_TOP], 1u);
            const unsigned tg = og / nx;
            if (og + 1u == (tg + 1u) * nx) xb_add(&bar[XB_TOPGEN], 1u);
            else XB_SPIN(xb_ld(&bar[XB_TOPGEN]) == tg, bar);
            __builtin_amdgcn_fence(__ATOMIC_ACQUIRE, "agent");
            xb_add(&bar[XB_XGEN(b.x)], 1u);
            asm volatile("s_waitcnt vmcnt(0)" ::: "memory");
        } else {
            XB_SPIN(xb_ld(&bar[XB_XGEN(b.x)]) == gen, bar);
            __builtin_amdgcn_fence(__ATOMIC_ACQUIRE, "agent");
            asm volatile("s_waitcnt vmcnt(0)" ::: "memory");
        }
    }
    __syncthreads();
}
typedef short s16x8 __attribute__((ext_vector_type(8)));
typedef float f32x16 __attribute__((ext_vector_type(16)));
typedef unsigned u32x2 __attribute__((ext_vector_type(2)));
__device__ __forceinline__ f32x16 mfma32(s16x8 a, s16x8 b, f32x16 c) { return __builtin_amdgcn_mfma_f32_32x32x16_bf16(a, b, c, 0, 0, 0); }
__device__ __forceinline__ s16x8 pack8(float a0, float a1, float a2, float a3, float a4, float a5, float a6, float a7) {
    v4u w; w.x = pk2(a0, a1); w.y = pk2(a2, a3); w.z = pk2(a4, a5); w.w = pk2(a6, a7); return __builtin_bit_cast(s16x8, w); }
__device__ __forceinline__ int rho(int t, int h2, int j) { return 16 * t + 8 * (j >> 2) + 4 * h2 + (j & 3); }

constexpr size_t DS_UNIT = 128 * 64;
constexpr size_t WS_DECAY = WS_DS + (size_t)16 * 128 * DS_UNIT * 2;
constexpr size_t WS_DSMETA = WS_DECAY + (size_t)16 * 128 * 64 * 4;
static_assert(WS_DSMETA + 4 * DS_UNIT * 4 <= WS_SS, "ds region");
static_assert(WS_SS + (size_t)16 * 128 * DS_UNIT * 2 <= WS_XS, "ss region");

__device__ __forceinline__ void gla_gate(const float* glr_rows, const float* wgu, const float* bg, int h, int lane, s16x8 (&laH)[2][2][2], s16x8 (&laL)[2][2][2]) {
    const int l31 = lane & 31, h2 = lane >> 5;
    s16x8 Wf[2];
#pragma unroll
    for (int Db = 0; Db < 2; ++Db) { const float* wp = wgu + (8 * h2) * 256 + h * 64 + 32 * Db + l31;
        Wf[Db] = pack8(wp[0], wp[256], wp[512], wp[768], wp[1024], wp[1280], wp[1536], wp[1792]); }
#pragma unroll
    for (int T = 0; T < 2; ++T) {
        const f32x4* gp = (const f32x4*)(glr_rows + (32 * T + l31) * 16 + 8 * h2); const f32x4 g0 = gp[0], g1 = gp[1];
        const s16x8 Gf = pack8(g0.x, g0.y, g0.z, g0.w, g1.x, g1.y, g1.z, g1.w);
#pragma unroll
        for (int Db = 0; Db < 2; ++Db) {
            const float bias = bg[h * 64 + 32 * Db + l31]; f32x16 acc;
#pragma unroll
            for (int r = 0; r < 16; ++r) acc[r] = bias;
            acc = mfma32(Gf, Wf[Db], acc);
            float hi[16], lo[16];
#pragma unroll
            for (int r = 0; r < 16; ++r) { const float z = acc[r]; const float la = (fminf(z, 0.f) - __logf(1.f + __expf(-fabsf(z)))) * 0.0625f;
                const float hf = __uint_as_float(f2bf(la) << 16); hi[r] = hf; lo[r] = la - hf; }
#pragma unroll
            for (int t = 0; t < 2; ++t) { laH[T][Db][t] = pack8(hi[8 * t], hi[8 * t + 1], hi[8 * t + 2], hi[8 * t + 3], hi[8 * t + 4], hi[8 * t + 5], hi[8 * t + 6], hi[8 * t + 7]);
                                          laL[T][Db][t] = pack8(lo[8 * t], lo[8 * t + 1], lo[8 * t + 2], lo[8 * t + 3], lo[8 * t + 4], lo[8 * t + 5], lo[8 * t + 6], lo[8 * t + 7]); }
        }
    }
}
__device__ __forceinline__ void tri_frags(int lane, s16x8 (&tri)[2], s16x8& ones) {
    const int l31 = lane & 31, h2 = lane >> 5;
#pragma unroll
    for (int t = 0; t < 2; ++t) { s16x8 f;
#pragma unroll
        for (int j = 0; j < 8; ++j) f[j] = (rho(t, h2, j) <= l31) ? (short)0x3F80 : (short)0;
        tri[t] = f; }
#pragma unroll
    for (int j = 0; j < 8; ++j) ones[j] = (short)0x3F80;
}
__device__ __forceinline__ s16x8 load_vfrag(const bf16* vcol, int T, int t, int h2) {
    s16x8 f;
#pragma unroll
    for (int j = 0; j < 8; ++j) f[j] = (short)vcol[(size_t)(32 * T + rho(t, h2, j)) * PC];
    return f;
}

__device__ __forceinline__ void gla_pass1_unit(const Args& a, int unit, int lane) {
    asm volatile("" : "+v"(lane));
    unsigned char* ws = a.ws;
    const int bh = unit >> 7, nm1 = unit & 127, b = bh >> 2, h = bh & 3, l31 = lane & 31, h2 = lane >> 5;
    const int m0 = b * SEQ + 64 * nm1;
    const bf16* proj = (const bf16*)(ws + WS_PROJ);
    s16x8 laH[2][2][2], laL[2][2][2];
    gla_gate((const float*)(ws + WS_GLR) + (size_t)m0 * 16, a.in[4], a.in[5], h, lane, laH, laL);
    s16x8 tri[2], ones; tri_frags(lane, tri, ones);
    f32x16 bA[2][2];
#pragma unroll
    for (int T = 0; T < 2; ++T)
#pragma unroll
        for (int Db = 0; Db < 2; ++Db) { f32x16 acc;
#pragma unroll
            for (int r = 0; r < 16; ++r) acc[r] = 0.f;
#pragma unroll
            for (int Ts = 0; Ts <= T; ++Ts)
#pragma unroll
                for (int t = 0; t < 2; ++t) { const s16x8 Lf = (Ts == T) ? tri[t] : ones; acc = mfma32(Lf, laH[Ts][Db][t], acc); acc = mfma32(Lf, laL[Ts][Db][t], acc); }
            bA[T][Db] = acc; }
    float blast[2];
#pragma unroll
    for (int Db = 0; Db < 2; ++Db) blast[Db] = __shfl(bA[1][Db][15], l31 + 32);
    if (h2 == 0) { float* dec = (float*)(ws + WS_DECAY) + (size_t)unit * 64; dec[l31] = __expf(blast[0]); dec[32 + l31] = __expf(blast[1]); }
    s16x8 ke[2][2][2];
#pragma unroll
    for (int Db = 0; Db < 2; ++Db) { const bf16* kcol = proj + (size_t)m0 * PC + C_K + h * 64 + 32 * Db + l31;
#pragma unroll
        for (int T = 0; T < 2; ++T)
#pragma unroll
            for (int t = 0; t < 2; ++t) { float kv[8];
#pragma unroll
                for (int j = 0; j < 8; ++j) kv[j] = bf2f(kcol[(size_t)(32 * T + rho(t, h2, j)) * PC]) * __expf(blast[Db] - bA[T][Db][8 * t + j]);
                ke[Db][T][t] = pack8(kv[0], kv[1], kv[2], kv[3], kv[4], kv[5], kv[6], kv[7]); } }
    bf16* dS = (bf16*)(ws + WS_DS) + (size_t)unit * DS_UNIT;
#pragma unroll 1
    for (int Vb = 0; Vb < 4; ++Vb) {
        const bf16* vcol = proj + (size_t)m0 * PC + C_V + h * 128 + 32 * Vb + l31;
        f32x16 acc0, acc1;
#pragma unroll
        for (int r = 0; r < 16; ++r) { acc0[r] = 0.f; acc1[r] = 0.f; }
#pragma unroll
        for (int T = 0; T < 2; ++T)
#pragma unroll
            for (int t = 0; t < 2; ++t) { const s16x8 Vf = load_vfrag(vcol, T, t, h2); acc0 = mfma32(ke[0][T][t], Vf, acc0); acc1 = mfma32(ke[1][T][t], Vf, acc1); }
        bf16* row = dS + (size_t)(32 * Vb + l31) * 64;
#pragma unroll
        for (int i = 0; i < 4; ++i) { u32x2 w0, w1; w0.x = pk2(acc0[4 * i], acc0[4 * i + 1]); w0.y = pk2(acc0[4 * i + 2], acc0[4 * i + 3]); w1.x = pk2(acc1[4 * i], acc1[4 * i + 1]); w1.y = pk2(acc1[4 * i + 2], acc1[4 * i + 3]);
            *(u32x2*)(row + 8 * i + 4 * h2) = w0; *(u32x2*)(row + 32 + 8 * i + 4 * h2) = w1; }
    }
}
__device__ __forceinline__ void gla_meta_unit(const Args& a, int mu, int lane) {
    const int h = mu >> 3, vs = mu & 7, d = lane;
    const float* mproj = (const float*)(a.ws + WS_MPROJ); const float* wgu = a.in[4]; const float* bg = a.in[5];
    float w[16];
#pragma unroll
    for (int r = 0; r < 16; ++r) w[r] = wgu[r * 256 + h * 64 + d];
    float bs[16], run = 0.f;
#pragma unroll
    for (int s = 0; s < 16; ++s) { float z = bg[h * 64 + d];
#pragma unroll
        for (int r = 0; r < 16; ++r) z += mproj[s * INC + C_G + r] * w[r];
        run += (fminf(z, 0.f) - log1pf(expf(-fabsf(z)))) * 0.0625f; bs[s] = run; }
    float ke[16];
#pragma unroll
    for (int s = 0; s < 16; ++s) ke[s] = mproj[s * INC + C_K + h * 64 + d] * expf(bs[15] - bs[s]);
    float* out = (float*)(a.ws + WS_DSMETA) + (size_t)h * DS_UNIT;
#pragma unroll 4
    for (int vv = 0; vv < 16; ++vv) { const int v = 16 * vs + vv; float acc = 0.f;
#pragma unroll
        for (int s = 0; s < 16; ++s) acc += ke[s] * mproj[s * INC + C_V + h * 128 + v];
        out[v * 64 + d] = acc; }
}
__device__ __forceinline__ void gla_scan(const Args& a, int gtid, int gthreads) {
    unsigned char* ws = a.ws;
    for (int id = gtid; id < 16 * 128 * 16; id += gthreads) {
        const int bh = id >> 11, v = (id >> 4) & 127, d4 = (id & 15) * 4, h = bh & 3;
        const f32x4 s0 = *(const f32x4*)((const float*)(ws + WS_DSMETA) + (size_t)h * DS_UNIT + v * 64 + d4);
        float S0 = s0.x, S1 = s0.y, S2 = s0.z, S3 = s0.w;
        const bf16* dS = (const bf16*)(ws + WS_DS) + (size_t)bh * 128 * DS_UNIT + v * 64 + d4;
        bf16* SS = (bf16*)(ws + WS_SS) + (size_t)bh * 128 * DS_UNIT + v * 64 + d4;
        const float* dec = (const float*)(ws + WS_DECAY) + (size_t)bh * 128 * 64 + d4;
#pragma unroll 1
        for (int n0 = 0; n0 < 128; n0 += 16) {
            u32x2 dv[16]; f32x4 dc[16];
#pragma unroll
            for (int i = 0; i < 16; ++i) { dv[i] = *(const u32x2*)(dS + (size_t)(n0 + i) * DS_UNIT); dc[i] = *(const f32x4*)(dec + (size_t)(n0 + i) * 64); }
#pragma unroll
            for (int i = 0; i < 16; ++i) {
                u32x2 o; o.x = pk2(S0, S1); o.y = pk2(S2, S3); *(u32x2*)(SS + (size_t)(n0 + i) * DS_UNIT) = o;
                S0 = dc[i].x * S0 + __uint_as_float(dv[i].x << 16); S1 = dc[i].y * S1 + __uint_as_float(dv[i].x & 0xffff0000u);
                S2 = dc[i].z * S2 + __uint_as_float(dv[i].y << 16); S3 = dc[i].w * S3 + __uint_as_float(dv[i].y & 0xffff0000u);
            }
        }
    }
}
__device__ __forceinline__ void gla_pass2_unit(const Args& a, int unit, int lane) {
    asm volatile("" : "+v"(lane));
    unsigned char* ws = a.ws;
    const int bh = unit >> 7, nm1 = unit & 127, b = bh >> 2, h = bh & 3, l31 = lane & 31, h2 = lane >> 5;
    const int m0 = b * SEQ + 64 * nm1;
    const bf16* proj = (const bf16*)(ws + WS_PROJ);
    s16x8 qt[2][4], kt[2][4];
    {
        s16x8 laH[2][2][2], laL[2][2][2];
        gla_gate((const float*)(ws + WS_GLR) + (size_t)m0 * 16, a.in[4], a.in[5], h, lane, laH, laL);
        s16x8 tri[2], ones; tri_frags(lane, tri, ones);
#pragma unroll
        for (int T = 0; T < 2; ++T)
#pragma unroll
            for (int Db = 0; Db < 2; ++Db) {
                f32x16 acc;
#pragma unroll
                for (int r = 0; r < 16; ++r) acc[r] = 0.f;
#pragma unroll
                for (int Ts = 0; Ts <= T; ++Ts)
#pragma unroll
                    for (int t = 0; t < 2; ++t) { const s16x8 Uf = (Ts == T) ? tri[t] : ones; acc = mfma32(laH[Ts][Db][t], Uf, acc); acc = mfma32(laL[Ts][Db][t], Uf, acc); }
                asm volatile("" ::: "memory");
                const bf16* qrow = proj + (size_t)(m0 + 32 * T + l31) * PC + C_Q + h * 64; const bf16* krow = qrow + (C_K - C_Q);
#pragma unroll
                for (int t = 0; t < 2; ++t) { const int ks = 2 * Db + t;
                    const u32x2 q0 = *(const u32x2*)(qrow + 16 * ks + 4 * h2), q1 = *(const u32x2*)(qrow + 16 * ks + 8 + 4 * h2);
                    const u32x2 k0 = *(const u32x2*)(krow + 16 * ks + 4 * h2), k1 = *(const u32x2*)(krow + 16 * ks + 8 + 4 * h2);
                    float e[8], qf[8], kf[8];
#pragma unroll
                    for (int j = 0; j < 8; ++j) e[j] = __expf(acc[8 * t + j]);
                    qf[0] = __uint_as_float(q0.x << 16); qf[1] = __uint_as_float(q0.x & 0xffff0000u); qf[2] = __uint_as_float(q0.y << 16); qf[3] = __uint_as_float(q0.y & 0xffff0000u);
                    qf[4] = __uint_as_float(q1.x << 16); qf[5] = __uint_as_float(q1.x & 0xffff0000u); qf[6] = __uint_as_float(q1.y << 16); qf[7] = __uint_as_float(q1.y & 0xffff0000u);
                    kf[0] = __uint_as_float(k0.x << 16); kf[1] = __uint_as_float(k0.x & 0xffff0000u); kf[2] = __uint_as_float(k0.y << 16); kf[3] = __uint_as_float(k0.y & 0xffff0000u);
                    kf[4] = __uint_as_float(k1.x << 16); kf[5] = __uint_as_float(k1.x & 0xffff0000u); kf[6] = __uint_as_float(k1.y << 16); kf[7] = __uint_as_float(k1.y & 0xffff0000u);
#pragma unroll
                    for (int j = 0; j < 8; ++j) { qf[j] = qf[j] * 0.125f * e[j]; kf[j] = kf[j] * __builtin_amdgcn_rcpf(e[j]); }
                    qt[T][ks] = pack8(qf[0], qf[1], qf[2], qf[3], qf[4], qf[5], qf[6], qf[7]);
                    kt[T][ks] = pack8(kf[0], kf[1], kf[2], kf[3], kf[4], kf[5], kf[6], kf[7]); }
            }
    }
    const bf16* St = (const bf16*)(ws + WS_SS) + (size_t)unit * DS_UNIT;
    const float* gnw = a.in[6];
    bf16* ymix = (bf16*)(ws + WS_YMIX);
#pragma unroll
    for (int C = 0; C < 2; ++C) {
        f32x16 Y[4];
#pragma unroll
        for (int Vb = 0; Vb < 4; ++Vb)
#pragma unroll
            for (int r = 0; r < 16; ++r) Y[Vb][r] = 0.f;
#pragma unroll
        for (int S = 0; S < 2; ++S) {
            if (S <= C) {
                f32x16 sc;
#pragma unroll
                for (int r = 0; r < 16; ++r) sc[r] = 0.f;
#pragma unroll
                for (int ks = 0; ks < 4; ++ks) sc = mfma32(kt[S][ks], qt[C][ks], sc);
                if (S == C) {
#pragma unroll
                    for (int r = 0; r < 16; ++r) { const int sl = (r & 3) + 8 * (r >> 2) + 4 * h2; if (sl > l31) sc[r] = 0.f; }
                }
                s16x8 P[2];
#pragma unroll
                for (int t = 0; t < 2; ++t) P[t] = pack8(sc[8 * t], sc[8 * t + 1], sc[8 * t + 2], sc[8 * t + 3], sc[8 * t + 4], sc[8 * t + 5], sc[8 * t + 6], sc[8 * t + 7]);
#pragma unroll
                for (int Vb = 0; Vb < 4; ++Vb) { const bf16* vcol = proj + (size_t)m0 * PC + C_V + h * 128 + 32 * Vb + l31;
#pragma unroll
                    for (int t = 0; t < 2; ++t) { const s16x8 Vf = load_vfrag(vcol, S, t, h2); Y[Vb] = mfma32(Vf, P[t], Y[Vb]); }
                    asm volatile("" ::: "memory"); }
            }
        }
#pragma unroll
        for (int Vb = 0; Vb < 4; ++Vb) { const bf16* srow = St + (size_t)(32 * Vb + l31) * 64;
#pragma unroll
            for (int ks = 0; ks < 4; ++ks) { const u32x2 s0 = *(const u32x2*)(srow + 16 * ks + 4 * h2), s1 = *(const u32x2*)(srow + 16 * ks + 8 + 4 * h2);
                v4u w; w.x = s0.x; w.y = s0.y; w.z = s1.x; w.w = s1.y; Y[Vb] = mfma32(__builtin_bit_cast(s16x8, w), qt[C][ks], Y[Vb]); }
            asm volatile("" ::: "memory"); }
        float ss = 0.f;
#pragma unroll
        for (int Vb = 0; Vb < 4; ++Vb)
#pragma unroll
            for (int r = 0; r < 16; ++r) ss += Y[Vb][r] * Y[Vb][r];
        ss += __shfl_xor(ss, 32);
        const float rs = rsqrtf(ss * (1.f / 128.f) + EPS);
        const int m = m0 + 32 * C + l31;
        const bf16* rrow = proj + (size_t)m * PC + C_R + h * 128; bf16* orow = ymix + (size_t)m * D + 512 + h * 128;
#pragma unroll
        for (int Vb = 0; Vb < 4; ++Vb) {
            asm volatile("" ::: "memory");
#pragma unroll
            for (int i = 0; i < 4; ++i) { const int v = 32 * Vb + 8 * i + 4 * h2;
                const u32x2 rr = *(const u32x2*)(rrow + v); const f32x4 gw = *(const f32x4*)(gnw + v);
                const float r0 = __uint_as_float(rr.x << 16), r1 = __uint_as_float(rr.x & 0xffff0000u), r2 = __uint_as_float(rr.y << 16), r3 = __uint_as_float(rr.y & 0xffff0000u);
                const float o0 = Y[Vb][4 * i] * rs * gw.x * (r0 / (1.f + __expf(-r0))), o1 = Y[Vb][4 * i + 1] * rs * gw.y * (r1 / (1.f + __expf(-r1)));
                const float o2 = Y[Vb][4 * i + 2] * rs * gw.z * (r2 / (1.f + __expf(-r2))), o3 = Y[Vb][4 * i + 3] * rs * gw.w * (r3 / (1.f + __expf(-r3)));
                u32x2 w; w.x = pk2(o0, o1); w.y = pk2(o2, o3); *(u32x2*)(orow + v) = w; }
        }
    }
}
template <int W>
__device__ __forceinline__ void pool_fill(const bf16* proj, const float* mproj, int b, int s0, int g, int lane, LAS unsigned char* tile) {
    constexpr int NR = 64 + W - 1;
    unsigned xr[NR];
    if (s0 >= W - 1) {
        const unsigned* p = (const unsigned*)(proj + (size_t)(b * SEQ + s0 - (W - 1)) * PC + g * 128 + 2 * lane);
#pragma unroll
        for (int i = 0; i < NR; ++i) xr[i] = p[(size_t)i * (PC / 2)];
    } else {
#pragma unroll
        for (int i = 0; i < NR; ++i) { const int s = s0 - (W - 1) + i;
            if (s >= 0) xr[i] = *(const unsigned*)(proj + (size_t)(b * SEQ + s) * PC + g * 128 + 2 * lane);
            else { const float* q = mproj + (NMETA + s) * INC + g * 128 + 2 * lane; xr[i] = pk2(q[0], q[1]); } }
    }
    float w0 = 0.f, w1 = 0.f;
#pragma unroll
    for (int i = 0; i < W - 1; ++i) { w0 += __uint_as_float(xr[i] << 16); w1 += __uint_as_float(xr[i] & 0xffff0000u); }
    constexpr float inv = 1.f / W;
#pragma unroll
    for (int tok = 0; tok < 64; ++tok) {
        const float x0 = __uint_as_float(xr[tok + W - 1] << 16), x1 = __uint_as_float(xr[tok + W - 1] & 0xffff0000u);
        w0 += x0; w1 += x1;
        *(LAS unsigned*)(tile + tok * 256 + ((4 * lane) ^ ((tok & 15) << 4))) = pk2(w0 * inv - x0, w1 * inv - x1);
        w0 -= __uint_as_float(xr[tok] << 16); w1 -= __uint_as_float(xr[tok] & 0xffff0000u);
    }
}
__device__ __forceinline__ void pool_unit(const Args& a, int unit, int lane, LAS unsigned char* tile) {
    asm volatile("" : "+v"(lane));
    unsigned char* ws = a.ws;
    const int tt = unit >> 2, g = unit & 3, m0 = 64 * tt, b = m0 / SEQ, s0 = m0 % SEQ, l31 = lane & 31, h2 = lane >> 5;
    const bf16* proj = (const bf16*)(ws + WS_PROJ); const float* mproj = (const float*)(ws + WS_MPROJ);
    if (g == 0) pool_fill<2>(proj, mproj, b, s0, g, lane, tile); else if (g == 1) pool_fill<4>(proj, mproj, b, s0, g, lane, tile);
    else if (g == 2) pool_fill<8>(proj, mproj, b, s0, g, lane, tile); else pool_fill<16>(proj, mproj, b, s0, g, lane, tile);
    LDS_WAIT(); asm volatile("" ::: "memory");
    s16x8 Pf[2][8];
#pragma unroll
    for (int T = 0; T < 2; ++T) { const int tok = 32 * T + l31;
#pragma unroll
        for (int ks = 0; ks < 8; ++ks) Pf[T][ks] = *(const LAS s16x8*)(tile + tok * 256 + ((32 * ks + 16 * h2) ^ ((tok & 15) << 4))); }
    LDS_WAIT(); asm volatile("" ::: "memory");
    const bf16* wt = (const bf16*)(ws + WS_POOLW) + g * 16384; const float* psc = a.in[8] + g * 128;
#pragma unroll 1
    for (int Nb = 0; Nb < 4; ++Nb) {
        f32x16 acc0, acc1;
#pragma unroll
        for (int r = 0; r < 16; ++r) { acc0[r] = 0.f; acc1[r] = 0.f; }
        const bf16* wrow = wt + (size_t)(32 * Nb + l31) * 128 + 8 * h2;
#pragma unroll
        for (int ks = 0; ks < 8; ++ks) { const s16x8 Wf = *(const s16x8*)(wrow + 16 * ks); acc0 = mfma32(Wf, Pf[0][ks], acc0); acc1 = mfma32(Wf, Pf[1][ks], acc1); }
#pragma unroll
        for (int i = 0; i < 4; ++i) { const int d = 32 * Nb + 8 * i + 4 * h2; const f32x4 sc = *(const f32x4*)(psc + d);
            u32x2 w0, w1; w0.x = pk2(acc0[4 * i] * sc.x, acc0[4 * i + 1] * sc.y); w0.y = pk2(acc0[4 * i + 2] * sc.z, acc0[4 * i + 3] * sc.w);
            w1.x = pk2(acc1[4 * i] * sc.x, acc1[4 * i + 1] * sc.y); w1.y = pk2(acc1[4 * i + 2] * sc.z, acc1[4 * i + 3] * sc.w);
            const int t0 = l31, t1 = 32 + l31;
            *(LAS u32x2*)(tile + t0 * 256 + ((2 * d) ^ ((t0 & 15) << 4))) = w0; *(LAS u32x2*)(tile + t1 * 256 + ((2 * d) ^ ((t1 & 15) << 4))) = w1; }
    }
    LDS_WAIT(); asm volatile("" ::: "memory");
    bf16* ymix = (bf16*)(ws + WS_YMIX);
#pragma unroll
    for (int it = 0; it < 16; ++it) { const int row = 4 * it + (lane >> 4), ch = lane & 15;
        const v4u v = *(const LAS v4u*)(tile + row * 256 + ((ch ^ (row & 15)) << 4));
        *(v4u*)(ymix + (size_t)(m0 + row) * D + g * 128 + ch * 8) = v; }
    LDS_WAIT(); asm volatile("" ::: "memory");
}
constexpr size_t RT_CLS = WS_ROUTE, RT_RANK = WS_ROUTE + 128 * 1024, RT_W = WS_ROUTE + 256 * 1024, RT_BCNT = WS_ROUTE + 512 * 1024,
                 RT_LIST = WS_ROUTE + 1 * MiB, RT_WS = WS_ROUTE + 1 * MiB + 512 * 1024, RT_SSQ = WS_ROUTE + 2 * MiB;
constexpr int HROWS = 38912;
static_assert(RT_SSQ + (size_t)TR * 16 * 4 <= WS_A0 && (size_t)HROWS * 512 * 2 <= WS_END - WS_H, "moe ws");
constexpr int LC_OFF = LDSCTL_OFF + 512, LC_TOT = LDSCTL_OFF + 640, LC_NT = LDSCTL_OFF + 760, LC_TCLS = LDSCTL_OFF + 1024;

__device__ __forceinline__ void p6_route(const Args& a, LAS unsigned char* lds, int vcu, int G) {
    const int tid = threadIdx.x, lane = tid & 63, wave = __builtin_amdgcn_readfirstlane(tid >> 6);
    unsigned char* ws = a.ws;
    LAS float* wr_t = (LAS float*)lds;
    LAS float* lgs = (LAS float*)(lds + 81920) + wave * 64;
    LAS int* bcls = (LAS int*)(lds + 81920 + 2048);
    { const float* nfw = a.in[10]; const float* wrg = a.in[11]; const float* wre = a.in[13];
      for (int i = tid; i < 4096; i += 512) { const int k = i >> 2, j = i & 3; wr_t[j * 1024 + k] = nfw[k] * wrg[i]; }
      for (int i = tid; i < 16384; i += 512) { const int k = i >> 4, e = i & 15; wr_t[(4 + e) * 1024 + k] = nfw[k] * wre[i]; } }
    __syncthreads();
    const float* brg = a.in[12]; const float* bre = a.in[14];
    int* rt_cls = (int*)(ws + RT_CLS); int* rt_rank = (int*)(ws + RT_RANK); float* rt_w = (float*)(ws + RT_W); int* bcnt = (int*)(ws + RT_BCNT);
    bf16* xn2 = (bf16*)(ws + WS_A0);
    for (int blk = vcu; blk < TR / 128; blk += G) {
        f32x4 v0[4], v1[4], n0[4], n1[4];
        { const GAS f32x4* x0 = (const GAS f32x4*)(a.out + (size_t)(128 * blk + 16 * wave) * D) + lane; const GAS f32x4* x1 = x0 + D / 4;
#pragma unroll
          for (int j = 0; j < 4; ++j) { v0[j] = x0[64 * j]; v1[j] = x1[64 * j]; } }
#pragma unroll 1
        for (int it = 0; it < 8; ++it) {
            const int m = 128 * blk + 16 * wave + 2 * it;
            { const int mn = it < 7 ? m + 2 : m;
              const GAS f32x4* x0 = (const GAS f32x4*)(a.out + (size_t)mn * D) + lane; const GAS f32x4* x1 = x0 + D / 4;
#pragma unroll
              for (int j = 0; j < 4; ++j) { n0[j] = x0[64 * j]; n1[j] = x1[64 * j]; } }
            float s0 = 0.f, s1 = 0.f;
#pragma unroll
            for (int j = 0; j < 4; ++j) { s0 += (v0[j].x * v0[j].x + v0[j].y * v0[j].y) + (v0[j].z * v0[j].z + v0[j].w * v0[j].w); s1 += (v1[j].x * v1[j].x + v1[j].y * v1[j].y) + (v1[j].z * v1[j].z + v1[j].w * v1[j].w); }
            s0 = wave_sum(s0); s1 = wave_sum(s1);
            const float r0 = rsqrtf(s0 * (1.f / D) + EPS), r1 = rsqrtf(s1 * (1.f / D) + EPS);
            GAS unsigned long long* o0 = (GAS unsigned long long*)(xn2 + (size_t)m * D) + lane; GAS unsigned long long* o1 = o0 + D / 4;
#pragma unroll
            for (int j = 0; j < 4; ++j) { o0[64 * j] = (unsigned long long)pk2(v0[j].x * r0, v0[j].y * r0) | ((unsigned long long)pk2(v0[j].z * r0, v0[j].w * r0) << 32);
                                          o1[64 * j] = (unsigned long long)pk2(v1[j].x * r1, v1[j].y * r1) | ((unsigned long long)pk2(v1[j].z * r1, v1[j].w * r1) << 32); }
            float ac[64];
#pragma unroll
            for (int q = 0; q < 64; ++q) ac[q] = 0.f;
#pragma unroll
            for (int q = 0; q < 20; ++q) { float t0 = 0.f, t1 = 0.f;
#pragma unroll
                for (int j = 0; j < 4; ++j) { const f32x4 w4 = *(const LAS f32x4*)(wr_t + q * 1024 + 4 * lane + 256 * j);
                    t0 += (v0[j].x * w4.x + v0[j].y * w4.y) + (v0[j].z * w4.z + v0[j].w * w4.w); t1 += (v1[j].x * w4.x + v1[j].y * w4.y) + (v1[j].z * w4.z + v1[j].w * w4.w); }
                ac[q] = t0; ac[32 + q] = t1; if (q & 1) asm volatile("" ::: "memory"); }
            float b32[32], b16[16], b8[8], b4[4], b2[2];
            { const bool hi = lane & 32;
#pragma unroll
              for (int i = 0; i < 32; ++i) { if ((i & 31) < 20) { const float keep = hi ? ac[32 + i] : ac[i], send = hi ? ac[i] : ac[32 + i]; b32[i] = keep + __shfl_xor(send, 32); } else b32[i] = 0.f; } }
            { const bool hi = lane & 16;
#pragma unroll
              for (int i = 0; i < 16; ++i) { const float keep = hi ? b32[16 + i] : b32[i], send = hi ? b32[i] : b32[16 + i]; b16[i] = keep + __shfl_xor(send, 16); } }
            { const bool hi = lane & 8;
#pragma unroll
              for (int i = 0; i < 8; ++i) { const float keep = hi ? b16[8 + i] : b16[i], send = hi ? b16[i] : b16[8 + i]; b8[i] = keep + __shfl_xor(send, 8); } }
            { const bool hi = lane & 4;
#pragma unroll
              for (int i = 0; i < 4; ++i) { const float keep = hi ? b8[4 + i] : b8[i], send = hi ? b8[i] : b8[4 + i]; b4[i] = keep + __shfl_xor(send, 4); } }
            { const bool hi = lane & 2;
#pragma unroll
              for (int i = 0; i < 2; ++i) { const float keep = hi ? b4[2 + i] : b4[i], send = hi ? b4[i] : b4[2 + i]; b2[i] = keep + __shfl_xor(send, 2); } }
            float b1; { const bool hi = lane & 1; const float keep = hi ? b2[1] : b2[0], send = hi ? b2[0] : b2[1]; b1 = keep + __shfl_xor(send, 1); }
            { const int rw = lane >> 5, j = lane & 31; const float bias = j < 4 ? brg[j] : (j < 20 ? bre[j - 4] : 0.f); lgs[lane] = b1 * (rw ? r1 : r0) + bias; }
            LDS_WAIT(); asm volatile("" ::: "memory");
            if ((lane & 31) == 0) {
                const int rw = lane >> 5; const LAS float* lg = lgs + 32 * rw;
                const float g0 = lg[0], g1 = lg[1], g2 = lg[2], g3 = lg[3];
                int g = 0; float gm = g0; if (g1 > gm) { gm = g1; g = 1; } if (g2 > gm) { gm = g2; g = 2; } if (g3 > gm) { gm = g3; g = 3; }
                const float pg = 1.f / (expf(g0 - gm) + expf(g1 - gm) + expf(g2 - gm) + expf(g3 - gm));
                const LAS float* el = lg + 4 + 4 * g; const float e0 = el[0], e1 = el[1], e2 = el[2], e3 = el[3];
                int i1 = 0; float m1 = e0; if (e1 > m1) { m1 = e1; i1 = 1; } if (e2 > m1) { m1 = e2; i1 = 2; } if (e3 > m1) { m1 = e3; i1 = 3; }
                int i2 = -1; float m2 = 0.f;
                if (i1 != 0) { m2 = e0; i2 = 0; }
                if (i1 != 1 && (i2 < 0 || e1 > m2)) { m2 = e1; i2 = 1; }
                if (i1 != 2 && (i2 < 0 || e2 > m2)) { m2 = e2; i2 = 2; }
                if (i1 != 3 && (i2 < 0 || e3 > m2)) { m2 = e3; i2 = 3; }
                const float p1 = 1.f / (1.f + expf(m2 - m1)), p2 = 1.f - p1;
                const int lo = i1 < i2 ? i1 : i2, hi = i1 < i2 ? i2 : i1;
                const int cls = 6 * g + (lo * (7 - lo)) / 2 + (hi - lo - 1);
                const float wlo = pg * (i1 == lo ? p1 : p2), whi = pg * (i1 == lo ? p2 : p1);
                rt_cls[m + rw] = cls; rt_w[2 * (m + rw)] = wlo; rt_w[2 * (m + rw) + 1] = whi;
                bcls[16 * wave + 2 * it + rw] = cls;
            }
            LDS_WAIT(); asm volatile("" ::: "memory");
#pragma unroll
            for (int j = 0; j < 4; ++j) { v0[j] = n0[j]; v1[j] = n1[j]; }
        }
        __syncthreads();
        if (tid < 128) { const int c = bcls[tid]; int rank = 0; for (int t = 0; t < tid; ++t) rank += (bcls[t] == c) ? 1 : 0; rt_rank[128 * blk + tid] = rank; }
        else if (tid < 160) { const int c = tid - 128; int n = 0; for (int t = 0; t < 128; ++t) n += (bcls[t] == c) ? 1 : 0; bcnt[blk * 32 + c] = n; }
        __syncthreads();
    }
}
__device__ __forceinline__ void p7_lists(const Args& a, LAS unsigned char* lds, int vcu, int G) {
    const int tid = threadIdx.x; unsigned char* ws = a.ws;
    const int* bcnt = (const int*)(ws + RT_BCNT); const int* rt_cls = (const int*)(ws + RT_CLS); const int* rt_rank = (const int*)(ws + RT_RANK); const float* rt_w = (const float*)(ws + RT_W);
    int* list = (int*)(ws + RT_LIST); float* wsorted = (float*)(ws + RT_WS);
    LAS int* ptot = (LAS int*)lds; LAS int* pbef = (LAS int*)(lds + 4096); LAS int* bef = (LAS int*)(lds + 8192);
    LAS int* cls_off = (LAS int*)(lds + LC_OFF); LAS int* cls_tot = (LAS int*)(lds + LC_TOT); LAS int* tilecls = (LAS int*)(lds + LC_TCLS); LAS int* ntl = (LAS int*)(lds + LC_NT);
    for (int blk = vcu; blk < TR / 128; blk += G) {
        __syncthreads();
        if (tid < 384) { const int c = tid >> 4, seg = tid & 15; int tot = 0, bf = 0;
#pragma unroll
            for (int j = 0; j < 16; ++j) { const int b2 = 16 * seg + j; const int v = bcnt[b2 * 32 + c]; tot += v; bf += (b2 < blk) ? v : 0; }
            ptot[tid] = tot; pbef[tid] = bf; }
        __syncthreads();
        if (tid < 24) { int tot = 0, bf = 0; for (int s = 0; s < 16; ++s) { tot += ptot[tid * 16 + s]; bf += pbef[tid * 16 + s]; } cls_tot[tid] = tot; bef[tid] = bf; }
        __syncthreads();
        if (tid == 0) { int off = 0, nt = 0; for (int c = 0; c < 24; ++c) { cls_off[c] = off; const int n = (cls_tot[c] + 255) >> 8; for (int i = 0; i < n; ++i) tilecls[nt++] = c; off += n * 256; } cls_off[24] = off; ntl[0] = nt; }
        __syncthreads();
        if (tid < 128) { const int m = 128 * blk + tid; const int c = rt_cls[m]; const int pos = cls_off[c] + bef[c] + rt_rank[m]; list[pos] = m; wsorted[2 * pos] = rt_w[2 * m]; wsorted[2 * pos + 1] = rt_w[2 * m + 1]; }
        if (blk == 0) { for (int c = 0; c < 24; ++c) { const int p0 = cls_off[c] + cls_tot[c], p1 = cls_off[c + 1]; for (int p = p0 + tid; p < p1; p += 512) { list[p] = 0; wsorted[2 * p] = 0.f; wsorted[2 * p + 1] = 0.f; } } }
    }
    __syncthreads();
}
__device__ __forceinline__ void p10_final(const Args& a, int gw, int NGW, int lane) {
    const float* ssqp = (const float*)(a.ws + RT_SSQ); const float* fnw = a.in[18];
    f32x4 w[4];
#pragma unroll
    for (int j = 0; j < 4; ++j) w[j] = *((const f32x4*)fnw + lane + 64 * j);
    for (int m = gw; m < TR; m += NGW) {
        const f32x4* sp = (const f32x4*)(ssqp + (size_t)m * 16); const f32x4 a0 = sp[0], a1 = sp[1], a2 = sp[2], a3 = sp[3];
        const float ss = (((a0.x + a0.y) + (a0.z + a0.w)) + ((a1.x + a1.y) + (a1.z + a1.w))) + (((a2.x + a2.y) + (a2.z + a2.w)) + ((a3.x + a3.y) + (a3.z + a3.w)));
        const float rs = rsqrtf(ss * (1.f / D) + EPS);
        GAS f32x4* row = (GAS f32x4*)(a.out + (size_t)m * D) + lane;
#pragma unroll
        for (int j = 0; j < 4; ++j) { f32x4 v = row[64 * j]; v = v * rs * w[j]; row[64 * j] = v; }
    }
}

__device__ __forceinline__ void transpose_item(const float* W, int ldw, const float* kscale, bf16* WT, int ldt, int k0, int n0, int drow0, LAS float* scr, int lane) {
    float tv[32];
#pragma unroll
    for (int i = 0; i < 32; ++i) { const int kk = 2 * i + (lane >> 5); tv[i] = W[(size_t)(k0 + kk) * ldw + n0 + (lane & 31)]; }
    if (kscale) {
#pragma unroll
        for (int i = 0; i < 32; ++i) tv[i] *= kscale[k0 + 2 * i + (lane >> 5)]; }
#pragma unroll
    for (int i = 0; i < 32; ++i) scr[(2 * i + (lane >> 5)) * 33 + (lane & 31)] = tv[i];
    LDS_WAIT(); asm volatile("" ::: "memory");
    const int c = lane & 7;
#pragma unroll
    for (int j = 0; j < 4; ++j) { const int n = (lane >> 3) + 8 * j; const LAS float* s = scr + (8 * c) * 33 + n;
        v4u o; o.x = pk2(s[0 * 33], s[1 * 33]); o.y = pk2(s[2 * 33], s[3 * 33]); o.z = pk2(s[4 * 33], s[5 * 33]); o.w = pk2(s[6 * 33], s[7 * 33]);
        *(GAS v4u*)(WT + (size_t)(drow0 + n) * ldt + k0 + 8 * c) = o; }
    LDS_WAIT(); asm volatile("" ::: "memory");
}

__device__ __forceinline__ void p0_prologue(const Args& a, LAS unsigned char* lds, int vcu, int G) {
    const int tid = threadIdx.x, lane = tid & 63, wave = __builtin_amdgcn_readfirstlane(tid >> 6);
    const float* x = a.in[0]; const float* meta = a.in[1]; const float* nmw = a.in[2]; const float* w_in = a.in[3];
    unsigned char* ws = a.ws;
#ifndef SKIP_C
    if (vcu < 33) {
        LAS float* mu_t = (LAS float*)lds;
        LAS float* red = (LAS float*)(lds + 65536);
        LAS float* mrs = (LAS float*)(lds + 65536 + 32768);
        for (int i = tid; i < 16 * 1024; i += 512) { const int r = i >> 10, k = i & 1023; mu_t[k * 16 + r] = meta[i] * nmw[k]; }
#pragma unroll
        for (int rr = 0; rr < 2; ++rr) { const int r = 2 * wave + rr; float s = 0.f;
            for (int j = 0; j < 16; ++j) { const float v = meta[r * 1024 + lane + 64 * j]; s += v * v; }
            s = wave_sum(s); if (lane == 0) mrs[r] = rsqrtf(s * (1.f / D) + EPS); }
        __syncthreads();
        const int n = vcu * 64 + lane, nn = n < INC ? n : INC - 1;
        float acc[16];
#pragma unroll
        for (int r = 0; r < 16; ++r) acc[r] = 0.f;
        const float* wp = w_in + (size_t)(128 * wave) * INC + nn;
#pragma unroll 32
        for (int k = 0; k < 128; ++k) { const float wv = wp[(size_t)k * INC]; const LAS f32x4* m4 = (const LAS f32x4*)(mu_t + (128 * wave + k) * 16);
#pragma unroll
            for (int q = 0; q < 4; ++q) { const f32x4 mm = m4[q]; acc[4 * q] += mm.x * wv; acc[4 * q + 1] += mm.y * wv; acc[4 * q + 2] += mm.z * wv; acc[4 * q + 3] += mm.w * wv; } }
#pragma unroll
        for (int r = 0; r < 16; ++r) red[(wave * 16 + r) * 64 + lane] = acc[r];
        __syncthreads();
#pragma unroll
        for (int rr = 0; rr < 2; ++rr) { const int r = 2 * wave + rr; float s = 0.f;
#pragma unroll
            for (int w = 0; w < 8; ++w) s += red[(w * 16 + r) * 64 + lane];
            if (n < INC) ((float*)(ws + WS_MPROJ))[r * INC + n] = s * mrs[r]; }
        __syncthreads();
    }
#endif
#ifndef SKIP_A
    {
        LAS float* scr = (LAS float*)(lds + wave * 16384);
        const int gw = vcu * NWAVES + wave, NGW = G * NWAVES;
        constexpr int I_IN = 16 * 64, I_PW = 4 * 8;
        for (int it0 = gw; it0 < I_IN + I_PW; it0 += NGW) {
            int it = it0;
            if (it < I_IN) { transpose_item(w_in, INC, nmw, (bf16*)(ws + WS_WIN), D, 64 * (it / 64), 32 * (it % 64), 32 * (it % 64), scr, lane); continue; } it -= I_IN;
            { const int g = it / 8, r = it % 8; transpose_item(a.in[7] + g * 16384, 128, nullptr, (bf16*)(ws + WS_POOLW) + g * 16384, 128, 64 * (r / 4), 32 * (r % 4), 32 * (r % 4), scr, lane); }
        }
    }
#endif
    __syncthreads();
#ifndef SKIP_B
    {
        LAS float* wg = (LAS float*)lds;
        for (int i = tid; i < 16 * 1024; i += 512) { const int k = i >> 4, q = i & 15; wg[q * 1024 + k] = nmw[k] * w_in[(size_t)k * INC + C_G + q]; }
        __syncthreads();
        const int gw = vcu * NWAVES + wave, NGW = G * NWAVES;
        float* rstd1 = (float*)(ws + WS_RSTD1); float* glr = (float*)(ws + WS_GLR); bf16* A0 = (bf16*)(ws + WS_A0);
        f32x4 v0[4], v1[4], n0[4], n1[4];
        if (gw < TR / 2) { const GAS f32x4* x0 = (const GAS f32x4*)(x + (size_t)(2 * gw) * D) + lane; const GAS f32x4* x1 = x0 + D / 4;
#pragma unroll
            for (int j = 0; j < 4; ++j) { v0[j] = x0[64 * j]; v1[j] = x1[64 * j]; } }
        for (int p = gw; p < TR / 2; p += NGW) {
            { const int pn = (p + NGW < TR / 2) ? p + NGW : p;
              const GAS f32x4* x0 = (const GAS f32x4*)(x + (size_t)(2 * pn) * D) + lane; const GAS f32x4* x1 = x0 + D / 4;
#pragma unroll
              for (int j = 0; j < 4; ++j) { n0[j] = x0[64 * j]; n1[j] = x1[64 * j]; } }
            float s0 = 0.f, s1 = 0.f;
#pragma unroll
            for (int j = 0; j < 4; ++j) { s0 += (v0[j].x * v0[j].x + v0[j].y * v0[j].y) + (v0[j].z * v0[j].z + v0[j].w * v0[j].w); s1 += (v1[j].x * v1[j].x + v1[j].y * v1[j].y) + (v1[j].z * v1[j].z + v1[j].w * v1[j].w); }
            s0 = wave_sum(s0); s1 = wave_sum(s1);
            const float r0 = rsqrtf(s0 * (1.f / D) + EPS), r1 = rsqrtf(s1 * (1.f / D) + EPS);
            GAS unsigned long long* o0 = (GAS unsigned long long*)(A0 + (size_t)(2 * p) * D) + lane; GAS unsigned long long* o1 = o0 + D / 4;
#pragma unroll
            for (int j = 0; j < 4; ++j) { o0[64 * j] = (unsigned long long)pk2(v0[j].x, v0[j].y) | ((unsigned long long)pk2(v0[j].z, v0[j].w) << 32);
                                          o1[64 * j] = (unsigned long long)pk2(v1[j].x, v1[j].y) | ((unsigned long long)pk2(v1[j].z, v1[j].w) << 32); }
            if (lane == 0) { rstd1[2 * p] = r0; rstd1[2 * p + 1] = r1; }
            float ac[32];
#pragma unroll
            for (int q = 0; q < 16; ++q) { float t0 = 0.f, t1 = 0.f;
#pragma unroll
                for (int j = 0; j < 4; ++j) { const f32x4 w4 = *(const LAS f32x4*)(wg + q * 1024 + 4 * lane + 256 * j);
                    t0 += (v0[j].x * w4.x + v0[j].y * w4.y) + (v0[j].z * w4.z + v0[j].w * w4.w); t1 += (v1[j].x * w4.x + v1[j].y * w4.y) + (v1[j].z * w4.z + v1[j].w * w4.w); }
                ac[q] = t0; ac[16 + q] = t1; if (q & 1) asm volatile("" ::: "memory"); }
            float b16[16], b8[8], b4[4], b2[2];
            { const bool hi = lane & 32;
#pragma unroll
              for (int i = 0; i < 16; ++i) { const float keep = hi ? ac[16 + i] : ac[i], send = hi ? ac[i] : ac[16 + i]; b16[i] = keep + __shfl_xor(send, 32); } }
            { const bool hi = lane & 16;
#pragma unroll
              for (int i = 0; i < 8; ++i) { const float keep = hi ? b16[8 + i] : b16[i], send = hi ? b16[i] : b16[8 + i]; b8[i] = keep + __shfl_xor(send, 16); } }
            { const bool hi = lane & 8;
#pragma unroll
              for (int i = 0; i < 4; ++i) { const float keep = hi ? b8[4 + i] : b8[i], send = hi ? b8[i] : b8[4 + i]; b4[i] = keep + __shfl_xor(send, 8); } }
            { const bool hi = lane & 4;
#pragma unroll
              for (int i = 0; i < 2; ++i) { const float keep = hi ? b4[2 + i] : b4[i], send = hi ? b4[i] : b4[2 + i]; b2[i] = keep + __shfl_xor(send, 4); } }
            float b1; { const bool hi = lane & 2; const float keep = hi ? b2[1] : b2[0], send = hi ? b2[0] : b2[1]; b1 = keep + __shfl_xor(send, 2); }
            b1 += __shfl_xor(b1, 1);
            if (!(lane & 1)) { const int rw = lane >> 5, q = (lane >> 1) & 15; glr[(size_t)(2 * p + rw) * 16 + q] = b1 * (rw ? r1 : r0); }
#pragma unroll
            for (int j = 0; j < 4; ++j) { v0[j] = n0[j]; v1[j] = n1[j]; }
        }
    }
#endif
}

__device__ __forceinline__ void late_weights(const Args& a, LAS float* scr, int widx, int nw, int lane) {
    unsigned char* ws = a.ws;
    constexpr int I_OUT = 16 * 32, I_GU = NEXP * 256, I_D = NEXP * 128;
    for (int it0 = widx; it0 < I_OUT + I_GU + I_D; it0 += nw) {
        int it = it0;
        if (it < I_OUT) { transpose_item(a.in[9], D, nullptr, (bf16*)(ws + WS_WOUT), D, 64 * (it / 32), 32 * (it % 32), 32 * (it % 32), scr, lane); continue; } it -= I_OUT;
        if (it < I_GU) { const int e = it / 256, r = it % 256, isup = r / 128, r2 = r % 128, kb = r2 / 8, nb = r2 % 8;
            const float* src = (isup ? a.in[16] : a.in[15]) + (size_t)e * D * EH;
            transpose_item(src, EH, a.in[10], (bf16*)(ws + WS_WGU) + (size_t)e * 512 * D, D, 64 * kb, 32 * nb, 256 * (nb >> 2) + 128 * isup + ((32 * nb) & 127), scr, lane); continue; } it -= I_GU;
        { const int e = it / 128, r = it % 128; transpose_item(a.in[17] + (size_t)e * EH * D, D, nullptr, (bf16*)(ws + WS_WD) + (size_t)e * D * EH, EH, 64 * (r / 32), 32 * (r % 32), 32 * (r % 32), scr, lane); }
    }
}

__global__ void __launch_bounds__(NWAVES * 64, 2) mega(Args args) {
    extern __shared__ __attribute__((aligned(16))) unsigned char lds_raw[];
    LAS unsigned char* lds = (LAS unsigned char*)lds_raw;
    const int tid = threadIdx.x;
    const int G = gridDim.x; int vcu; { const int bx = blockIdx.x; vcu = (G % 8 == 0) ? (bx % 8) * (G / 8) + bx / 8 : bx; }
    for (int u = tid; u < (LDS_BYTES - LDSCTL_OFF) / 4; u += NWAVES * 64) ((LAS unsigned*)(lds + LDSCTL_OFF))[u] = 0u;
    __syncthreads();
    XcdBarrier bar = xcd_barrier_post((unsigned*)(args.ws + WS_CTL) + CW_BAR, (volatile LAS unsigned*)(lds + MISC_OFF) + 8);
    const int lo = args.ph_lo, hi = args.ph_hi;
#ifndef PROBE_REP
#define PROBE_REP -1
#endif
#define REP(k) for (int rep_ = 0; rep_ < ((PROBE_REP == (k)) ? 2 : 1); ++rep_)
#define IN(k) (lo <= (k) && (k) < hi)
#define BOTH(k) (IN(k) && IN((k) + 1))
    unsigned char* ws = args.ws;
    if (IN(0)) REP(0) { p0_prologue(args, lds, vcu, G); if (BOTH(0)) xcd_barrier(bar); }
    if (IN(1)) REP(1) {
        pg8::DenseOrder S; S.init(TR, PC, G, (int)blockIdx.x); S.lda = D; S.ldb = D; S.Bt = (const char*)(ws + WS_WIN); S.bsplit = 1 << 30;
        pg8::EpiRowScaleBf16 E{(bf16*)(ws + WS_PROJ), PC, (const float*)(ws + WS_RSTD1)};
        pg8::gemm_phase2<pg8::EpiRowScaleBf16, pg8::DenseOrder, PG8_ALIGN>(lds + RING_OFF, (const char*)(ws + WS_A0), D, D, S, E);
        if (BOTH(1)) xcd_barrier(bar);
    }
    const int wave_ = __builtin_amdgcn_readfirstlane(tid >> 6), lane_ = tid & 63, gw_ = vcu * NWAVES + wave_, NGW_ = G * NWAVES;
    if (IN(2)) REP(2) {
        if (gw_ < 32) gla_meta_unit(args, gw_, lane_);
        for (int u = gw_; u < 2048; u += NGW_) gla_pass1_unit(args, u, lane_);
        for (int u = gw_; u < 2048; u += NGW_) pool_unit(args, u, lane_, lds + wave_ * 16384);
        if (BOTH(2)) xcd_barrier(bar);
    }
    if (IN(3)) REP(3) {
        if (wave_ < 2) gla_scan(args, (wave_ * G + vcu) * 64 + lane_, 2 * G * 64);
        else late_weights(args, (LAS float*)(lds + wave_ * 16384), (wave_ - 2) * G + vcu, 6 * G, lane_);
        if (BOTH(3)) xcd_barrier(bar); }
    if (IN(4)) REP(4) { for (int u = gw_; u < 2048; u += NGW_) gla_pass2_unit(args, u, lane_); if (BOTH(4)) xcd_barrier(bar); }
    if (IN(5)) REP(5) {
        pg8::DenseOrder S; S.init(TR, D, G, (int)blockIdx.x); S.lda = D; S.ldb = D; S.Bt = (const char*)(ws + WS_WOUT); S.bsplit = 1 << 30;
        pg8::EpiResF32 E{args.out, args.in[0], D};
        pg8::gemm_phase2<pg8::EpiResF32, pg8::DenseOrder, PG8_ALIGN>(lds + RING_OFF, (const char*)(ws + WS_YMIX), D, D, S, E);
        if (BOTH(5)) xcd_barrier(bar);
    }
    if (IN(6)) REP(6) { p6_route(args, lds, vcu, G); if (BOTH(6)) xcd_barrier(bar); }
    if (IN(7)) REP(7) { p7_lists(args, lds, vcu, G); if (BOTH(7)) xcd_barrier(bar); }
    if (IN(8) || IN(9)) {
        pg8::MoeTables T{(const LAS int*)(lds + LC_OFF), (const LAS int*)(lds + LC_TOT), (const LAS int*)(lds + LC_TCLS), *(const LAS int*)(lds + LC_NT)};
        if (IN(8)) REP(8) {
            pg8::MoeUpOrder S{T, G, (int)blockIdx.x, (const int*)(ws + RT_LIST), (const char*)(ws + WS_WGU), 1 << 30};
            pg8::EpiSwiGLU E{(bf16*)(ws + WS_H), (const float*)(ws + RT_WS)};
            pg8::gemm_phase2<pg8::EpiSwiGLU, pg8::MoeUpOrder, PG8_ALIGN>(lds + RING_OFF, (const char*)(ws + WS_A0), D, D, S, E);
            if (BOTH(8)) xcd_barrier(bar);
        }
        if (IN(9)) {
            pg8::MoeDownOrder S{T, G, (int)blockIdx.x, (const char*)(ws + WS_WD), 4};
            pg8::EpiDownScatter E{args.out, (const int*)(ws + RT_LIST), (float*)(ws + RT_SSQ)};
            pg8::gemm_phase2<pg8::EpiDownScatter, pg8::MoeDownOrder, PG8_ALIGN>(lds + RING_OFF, (const char*)(ws + WS_H), 512, EH, S, E);
            if (BOTH(9)) xcd_barrier(bar);
        }
    }
    if (IN(10)) p10_final(args, gw_, NGW_, lane_);
#undef IN
#undef BOTH
}
#ifndef MEGA_PHASES
#define MEGA_PHASES 11
#endif
extern "C" void kernel_launch(void* const* d_in, const int* in_sizes, int n_in, void* d_out, int out_size, void* d_ws, size_t ws_size, hipStream_t stream) {
    static int grid = 0;
    if (grid == 0) {
        if (n_in != 19 || in_sizes[0] != TR * D || out_size != TR * D || ws_size < WS_END) { fprintf(stderr, "kernel_launch: unexpected shapes (n_in %d in0 %d out %d ws %zu); nothing launched\n", n_in, n_in > 0 ? in_sizes[0] : -1, out_size, ws_size); grid = -1; return; }
        int dev = 0, cus = 0, per_cu = 0;
        if (hipGetDevice(&dev) != hipSuccess || hipDeviceGetAttribute(&cus, hipDeviceAttributeMultiprocessorCount, dev) != hipSuccess) { grid = -1; return; }
        if (hipFuncSetAttribute((const void*)mega, hipFuncAttributeMaxDynamicSharedMemorySize, LDS_BYTES) != hipSuccess) { fprintf(stderr, "kernel_launch: hipFuncSetAttribute failed\n"); grid = -1; return; }
        if (hipOccupancyMaxActiveBlocksPerMultiprocessor(&per_cu, (const void*)mega, NWAVES * 64, LDS_BYTES) != hipSuccess || per_cu < 1) { fprintf(stderr, "kernel_launch: occupancy query says %d blocks/CU\n", per_cu); grid = -1; return; }
        grid = cus;
        fprintf(stderr, "kernel_launch: cus %d per_cu %d grid %d\n", cus, per_cu, grid);
    }
    if (grid < 0) return;
    if (hipMemsetAsync((char*)d_ws + WS_CTL, 0, CTL_ZERO_BYTES, stream) != hipSuccess) return;
    Args a{};
    for (int i = 0; i < 19; ++i) a.in[i] = (const float*)d_in[i];
    a.out = (float*)d_out; a.ws = (unsigned char*)d_ws; a.ph_lo = 0; a.ph_hi = MEGA_PHASES;
    void* kargs[] = {&a};
    hipError_t le = hipLaunchCooperativeKernel((const void*)mega, dim3(grid), dim3(NWAVES * 64), kargs, LDS_BYTES, stream);
    if (le != hipSuccess) { fprintf(stderr, "kernel_launch: cooperative launch failed: %s (grid %d)\n", hipGetErrorName(le), grid); return; }

}
```
